# Optimizing an MI355X kernel written in HIP

```python
import math
import jax, jax.numpy as jnp
from jax import lax
import numpy as np


D_MODEL = 2048
BATCH = 16
SEQ = 2048
DEPTH = 4
DEC_BATCH = 32
DEC_SEQ = 32
PAST_LEN = 4096

CHUNK = 64
D_MIX = D_MODEL
HEAD_DIM = 64
D_ATTN = D_MIX // 2
D_GMLP = D_MIX - D_ATTN
N_HEADS = D_ATTN // HEAD_DIM
N_KV_HEADS = 4
GQA_GROUP = N_HEADS // N_KV_HEADS
D_KV = N_KV_HEADS * HEAD_DIM
WINDOW = 128
N_WIN_CHUNKS = WINDOW // CHUNK
N_BUCKETS = 32
MAX_DISTANCE = 128
GMLP_CHUNK = 128
N_GROUPS_B = D_GMLP // HEAD_DIM
D_PROJ = D_ATTN + 2 * D_KV + D_ATTN + 3 * D_GMLP
EPS = 1e-6
NEG_INF = -1e30

kernel_name = 'hymba_swa_sink_gmlp_stream_step'


def _rmsnorm(x, g):
    xf = x.astype(jnp.float32)
    y = xf * lax.rsqrt(jnp.mean(xf * xf, axis=-1, keepdims=True) + EPS)
    return (y * g.astype(jnp.float32)).astype(x.dtype)


def _layernorm(x, g, b):
    xf = x.astype(jnp.float32)
    mu = jnp.mean(xf, axis=-1, keepdims=True)
    xc = xf - mu
    y = xc * lax.rsqrt(jnp.mean(xc * xc, axis=-1, keepdims=True) + EPS)
    return (y * g.astype(jnp.float32) + b.astype(jnp.float32)).astype(x.dtype)


def _rel_bucket(rel):
    nb = N_BUCKETS // 2
    max_exact = nb // 2
    base = jnp.where(rel > 0, nb, 0)
    n = jnp.abs(rel)
    nf = jnp.maximum(n, 1).astype(jnp.float32)
    large = max_exact + (jnp.log(nf / max_exact) / math.log(MAX_DISTANCE / max_exact)
                         * (nb - max_exact)).astype(jnp.int32)
    large = jnp.minimum(large, nb - 1)
    return base + jnp.where(n < max_exact, n, large)


def _band_bias(rel_bias, n_q, n_past):
    i = jnp.arange(n_q)[:, None]
    j = jnp.arange(n_past + n_q)[None, :]
    b = rel_bias[_rel_bucket(j - n_past - i)]
    b = jnp.transpose(b, (2, 0, 1)).astype(jnp.float32)
    return b.reshape(N_KV_HEADS, GQA_GROUP, n_q, n_past + n_q)


def _band_attention(q, k, v, bias, valid, sinks):
    s = jnp.einsum('bnqhgd,bnkhd->bnhgqk', q, k).astype(jnp.float32) * (HEAD_DIM ** -0.5) + bias
    s = jnp.where(valid[None, :, None, None, None, :], s, NEG_INF)
    sink = sinks.astype(jnp.float32).reshape(N_KV_HEADS, GQA_GROUP)[None, None, :, :, None, None]
    m = jnp.maximum(jnp.max(s, axis=-1, keepdims=True), sink)
    p = jnp.exp(s - m)
    p = p / (jnp.sum(p, axis=-1, keepdims=True) + jnp.exp(sink - m))
    return jnp.einsum('bnhgqk,bnkhd->bnqhgd', p.astype(v.dtype), v)


def _project(x, g_in, w_in, ln_g, ln_b):
    B, S = x.shape[0], x.shape[1]
    h = _rmsnorm(x, g_in)
    p = jnp.einsum('bsd,de->bse', h, w_in)
    o1 = D_ATTN
    o2 = o1 + D_KV
    o3 = o2 + D_KV
    o4 = o3 + D_ATTN
    o5 = o4 + D_GMLP
    o6 = o5 + D_GMLP
    q = p[..., :o1].reshape(B, S, N_KV_HEADS, GQA_GROUP, HEAD_DIM)
    k = p[..., o1:o2].reshape(B, S, N_KV_HEADS, HEAD_DIM)
    v = p[..., o2:o3].reshape(B, S, N_KV_HEADS, HEAD_DIM)
    gate_a = p[..., o3:o4]
    u = jax.nn.gelu(p[..., o4:o5], approximate=False).reshape(B, S, N_GROUPS_B, HEAD_DIM)
    vg = _layernorm(jax.nn.gelu(p[..., o5:o6], approximate=False), ln_g, ln_b)
    vg = vg.reshape(B, S, N_GROUPS_B, HEAD_DIM)
    gate_b = p[..., o6:]
    return q, k, v, gate_a, u, vg, gate_b


def _attn_prompt(q, k, v, rel_bias, sinks):
    B, S = q.shape[0], q.shape[1]
    nC = S // CHUNK
    qc = q.reshape(B, nC, CHUNK, N_KV_HEADS, GQA_GROUP, HEAD_DIM)

    def band(t):
        tc = t.reshape(B, nC, CHUNK, N_KV_HEADS, HEAD_DIM)
        pad = jnp.zeros((B, N_WIN_CHUNKS, CHUNK, N_KV_HEADS, HEAD_DIM), t.dtype)
        tp = jnp.concatenate([pad, tc], axis=1)
        return jnp.concatenate([tp[:, w:w + nC] for w in range(N_WIN_CHUNKS + 1)], axis=2)

    kb = band(k)
    vb = band(v)
    key_pos = (jnp.arange(nC)[:, None] - N_WIN_CHUNKS) * CHUNK + jnp.arange(WINDOW + CHUNK)[None, :]
    valid = key_pos >= 0
    bias = _band_bias(rel_bias, CHUNK, WINDOW)
    o = _band_attention(qc, kb, vb, bias, valid, sinks)
    return o.reshape(B, S, D_ATTN), k[:, -WINDOW:], v[:, -WINDOW:]


def _attn_sample(q, k, v, ck, cv, rel_bias, sinks):
    B, T = q.shape[0], q.shape[1]
    n_past = ck.shape[1]
    kb = jnp.concatenate([ck, k.astype(ck.dtype)], axis=1)
    vb = jnp.concatenate([cv, v.astype(cv.dtype)], axis=1)
    bias = _band_bias(rel_bias, T, n_past)
    valid = jnp.ones((1, n_past + T), dtype=bool)
    o = _band_attention(q[:, None], kb[:, None], vb[:, None], bias, valid, sinks)
    return o.reshape(B, T, D_ATTN), kb[:, T:], vb[:, T:]


def _gmlp_mix(u, vg, w_s, b_s):
    L = vg.shape[2]
    ws = jnp.tril(w_s[:, :L, :L]).astype(vg.dtype)
    mix = jnp.einsum('gij,bcjgd->bcigd', ws, vg) + b_s[:, :L].T.astype(vg.dtype)[None, None, :, :, None]
    return u * mix


def _merge(attn_o, gmlp_o, gate_a, gate_b, g_attn, g_gmlp, w_out):
    ya = _rmsnorm(attn_o, g_attn) * jax.nn.silu(gate_a)
    yb = _rmsnorm(gmlp_o, g_gmlp) * jax.nn.silu(gate_b)
    return jnp.einsum('bse,ed->bsd', jnp.concatenate([ya, yb], axis=-1), w_out)


def setup_inputs(seed: int = 0) -> dict:
    key = jax.random.key(seed)
    ks = jax.random.split(key, 16)
    cache_rows = min(WINDOW, PAST_LEN)
    f32 = jnp.float32
    tril = jnp.tril(jnp.ones((GMLP_CHUNK, GMLP_CHUNK), f32))
    return {
        'x_prompt': jax.random.normal(ks[0], (BATCH, SEQ, D_MODEL), f32),
        'x_sample': jax.random.normal(ks[1], (DEC_BATCH, DEC_SEQ, D_MODEL), f32),
        'cache_k': jax.random.normal(ks[2], (DEPTH, DEC_BATCH, cache_rows, N_KV_HEADS, HEAD_DIM), f32),
        'cache_v': jax.random.normal(ks[3], (DEPTH, DEC_BATCH, cache_rows, N_KV_HEADS, HEAD_DIM), f32),
        'w_in': jax.random.normal(ks[4], (DEPTH, D_MODEL, D_PROJ), f32) * D_MODEL ** -0.5,
        'w_out': jax.random.normal(ks[5], (DEPTH, D_MIX, D_MODEL), f32) * D_MIX ** -0.5,
        'norm_in': 1.0 + 0.01 * jax.random.normal(ks[6], (DEPTH, D_MODEL), f32),
        'rel_bias': 0.1 * jax.random.normal(ks[7], (N_BUCKETS, N_HEADS), f32),
        'sinks': 0.5 * jax.random.normal(ks[8], (DEPTH, N_HEADS), f32),
        'norm_attn': 1.0 + 0.01 * jax.random.normal(ks[9], (DEPTH, D_ATTN), f32),
        'norm_gmlp': 1.0 + 0.01 * jax.random.normal(ks[10], (DEPTH, D_GMLP), f32),
        'ln_v_g': 1.0 + 0.01 * jax.random.normal(ks[11], (DEPTH, D_GMLP), f32),
        'ln_v_b': 0.01 * jax.random.normal(ks[12], (DEPTH, D_GMLP), f32),
        'w_spatial': jax.random.normal(ks[13], (DEPTH, N_GROUPS_B, GMLP_CHUNK, GMLP_CHUNK), f32)
                     * tril * GMLP_CHUNK ** -0.5,
        'b_spatial': 1.0 + 0.01 * jax.random.normal(ks[14], (DEPTH, N_GROUPS_B, GMLP_CHUNK), f32),
        'norm_final': 1.0 + 0.01 * jax.random.normal(ks[15], (D_MODEL,), f32),
    }


def reference(x_prompt, x_sample, cache_k, cache_v, w_in, w_out, norm_in, rel_bias, sinks,
              norm_attn, norm_gmlp, ln_v_g, ln_v_b, w_spatial, b_spatial, norm_final):
    xp = x_prompt
    xs = x_sample
    Bp, S = xp.shape[0], xp.shape[1]
    Bs, T = xs.shape[0], xs.shape[1]
    n_gchunks = S // GMLP_CHUNK
    kp_rows, vp_rows, ks_rows, vs_rows, vg_rows = [], [], [], [], []
    for l in range(DEPTH):
        q, k, v, ga, u, vg, gb = _project(xp, norm_in[l], w_in[l], ln_v_g[l], ln_v_b[l])
        ao, kw, vw = _attn_prompt(q, k, v, rel_bias, sinks[l])
        go = _gmlp_mix(u.reshape(Bp, n_gchunks, GMLP_CHUNK, N_GROUPS_B, HEAD_DIM),
                       vg.reshape(Bp, n_gchunks, GMLP_CHUNK, N_GROUPS_B, HEAD_DIM),
                       w_spatial[l], b_spatial[l]).reshape(Bp, S, D_GMLP)
        xp = xp + _merge(ao, go, ga, gb, norm_attn[l], norm_gmlp[l], w_out[l])
        kp_rows.append(kw)
        vp_rows.append(vw)
        q, k, v, ga, u, vg, gb = _project(xs, norm_in[l], w_in[l], ln_v_g[l], ln_v_b[l])
        ao, kw, vw = _attn_sample(q, k, v, cache_k[l], cache_v[l], rel_bias, sinks[l])
        go = _gmlp_mix(u[:, None], vg[:, None], w_spatial[l], b_spatial[l]).reshape(Bs, T, D_GMLP)
        xs = xs + _merge(ao, go, ga, gb, norm_attn[l], norm_gmlp[l], w_out[l])
        ks_rows.append(kw)
        vs_rows.append(vw)
        vg_rows.append(vg)
    y_prompt = _rmsnorm(xp, norm_final)
    y_sample = _rmsnorm(xs, norm_final)
    new_k_prompt = jnp.stack(kp_rows)
    new_v_prompt = jnp.stack(vp_rows)
    new_k_sample = jnp.stack(ks_rows)
    new_v_sample = jnp.stack(vs_rows)
    new_vgmlp_sample = jnp.stack(vg_rows)
    return (y_prompt, y_sample, new_k_prompt, new_v_prompt, new_k_sample, new_v_sample, new_vgmlp_sample)
```

```cpp
#include <hip/hip_runtime.h>
#include <hip/hip_cooperative_groups.h>
#include <cstdio>
#include <cstdint>
namespace cg = cooperative_groups;

#define LAS __attribute__((address_space(3)))
typedef unsigned short bf16_t;
typedef short bf16x8 __attribute__((ext_vector_type(8)));
typedef short s16x4 __attribute__((ext_vector_type(4)));
typedef float f32x4 __attribute__((ext_vector_type(4)));
typedef float f32x2 __attribute__((ext_vector_type(2)));
typedef float f32x16 __attribute__((ext_vector_type(16)));
typedef unsigned u32x4 __attribute__((ext_vector_type(4)));
typedef unsigned u32x2 __attribute__((ext_vector_type(2)));

constexpr int DM = 2048, NP = 16 * 2048, NS = 32 * 32, MT = NP + NS, DPROJ = 5632, DEPTH = 4;
constexpr int O_Q = 0, O_K = 1024, O_V = 1280, O_GA = 1536, O_U = 2560, O_VG = 3584, O_GB = 4608;
constexpr float EPS = 1e-6f, LOG2E = 1.4426950408889634f;
constexpr size_t OUT_KNP = (size_t)MT * DM, OUT_NVP = OUT_KNP + 2097152, OUT_NKS = OUT_NVP + 2097152, OUT_NVS = OUT_NKS + 4194304, OUT_VGS = OUT_NVS + 4194304;
constexpr size_t MiB = 1u << 20;
constexpr size_t WS_WIN = 0, WS_WOUT = 88 * MiB, WS_XB = 120 * MiB, WS_P = 252 * MiB, WS_Y = 616 * MiB, WS_SSX = 748 * MiB, WS_SVG = 753 * MiB, WS_SSA = 758 * MiB, WS_SSB = 761 * MiB, WS_CNT = 766 * MiB, WS_END = 767 * MiB;
static_assert((size_t)DEPTH * DPROJ * DM * 2 <= WS_WOUT && WS_WOUT + (size_t)DEPTH * DM * DM * 2 <= WS_XB && WS_XB + (size_t)MT * DM * 2 <= WS_P && WS_P + (size_t)MT * DPROJ * 2 <= WS_Y && WS_Y + (size_t)MT * DM * 2 <= WS_SSX, "ws map");
constexpr int LDS_BYTES = 163840, L_ROWS = 131072;

struct Params {
    const float *x_prompt, *x_sample, *cache_k, *cache_v, *w_in, *w_out, *norm_in, *rel_bias, *sinks, *norm_attn, *norm_gmlp, *ln_v_g, *ln_v_b, *w_spatial, *b_spatial, *norm_final;
    float* out; unsigned char* ws;
};

__device__ __forceinline__ unsigned f2bf(float f) { unsigned u = __builtin_bit_cast(unsigned, f); return (u + 0x7fffu + ((u >> 16) & 1u)) >> 16; }
typedef __bf16 bf16x2_t __attribute__((ext_vector_type(2)));
__device__ __forceinline__ unsigned pk2(float lo, float hi) { const f32x2 v = {lo, hi}; return __builtin_bit_cast(unsigned, __builtin_convertvector(v, bf16x2_t)); }
__device__ __forceinline__ float bf_lo(unsigned w) { return __builtin_bit_cast(float, w << 16); }
__device__ __forceinline__ float bf_hi(unsigned w) { return __builtin_bit_cast(float, w & 0xffff0000u); }
__device__ __forceinline__ float wave_sum(float v) {
#pragma unroll
    for (int o = 1; o < 64; o <<= 1) v += __shfl_xor(v, o);
    return v;
}
__device__ __forceinline__ int lane_fresh() { int l; asm volatile("v_mbcnt_lo_u32_b32 %0, -1, 0\n\tv_mbcnt_hi_u32_b32 %0, -1, %0" : "=v"(l)); return l; }
__device__ __forceinline__ void swap_halves(float& a, float& b) {
    const auto r = __builtin_amdgcn_permlane32_swap(__builtin_bit_cast(unsigned, a), __builtin_bit_cast(unsigned, b), false, false);
    unsigned x = r[0], y = r[1];
    asm volatile("" : "+v"(x), "+v"(y));
    a = __builtin_bit_cast(float, x); b = __builtin_bit_cast(float, y);
}
__device__ __forceinline__ float sum4(f32x4 v) { return (v[0] + v[1]) + (v[2] + v[3]); }
__device__ __forceinline__ float fq_sum(float v) { v += __shfl_xor(v, 16); v += __shfl_xor(v, 32); return v; }
__device__ __forceinline__ float silu_f(float v) { return v * __builtin_amdgcn_rcpf(1.0f + __builtin_amdgcn_exp2f(-v * LOG2E)); }
__device__ __forceinline__ f32x2 gelu_pk(f32x2 v) {
    f32x2 vc; vc.x = __builtin_amdgcn_fmed3f(v.x, -4.5f, 4.5f); vc.y = __builtin_amdgcn_fmed3f(v.y, -4.5f, 4.5f);
    const f32x2 t = vc * vc;
    f32x2 q = t * (-1.400032542e-12f) + 1.697268853e-10f;
    q = q * t + (-9.193600548e-09f); q = q * t + 2.958863661e-07f; q = q * t + (-6.365206445e-06f); q = q * t + 9.787092858e-05f;
    q = q * t + (-1.122676185e-03f); q = q * t + 9.833178483e-03f; q = q * t + (-6.633704901e-02f); q = q * t + 3.988837898e-01f;
    const f32x2 ph = vc * q + 0.5f;
    return v * ph;
}
__device__ __forceinline__ f32x4 gelu4(f32x4 v) { f32x2 a = gelu_pk((f32x2){v[0], v[1]}), b = gelu_pk((f32x2){v[2], v[3]}); return (f32x4){a.x, a.y, b.x, b.y}; }
__device__ __forceinline__ f32x4 silu4(f32x4 v) { return (f32x4){silu_f(v[0]), silu_f(v[1]), silu_f(v[2]), silu_f(v[3])}; }
__device__ __forceinline__ u32x4 pack8(f32x4 a, f32x4 b) { u32x4 w; w.x = pk2(a[0], a[1]); w.y = pk2(a[2], a[3]); w.z = pk2(b[0], b[1]); w.w = pk2(b[2], b[3]); return w; }

namespace pg8 {
constexpr int BM = 256, BK = 64, HALF = 128, HTB = HALF * BK * 2, STAGE_BYTES = 8 * HTB, NXCD = 8, WGM = 2;
__device__ __forceinline__ int lds_byte(int r, int c) { const int st = (r >> 4) * 2 + (c >> 5), rr = r & 15, cc = c & 31, ob = rr * 64 + cc * 2; return st * 1024 + (ob ^ (((ob >> 9) & 1) << 5)); }
__device__ __forceinline__ void stage_rc(int b, int& R, int& C) { const int st = b / 1024, sb = b % 1024, swz = sb ^ (((sb >> 9) & 1) << 5); R = (st >> 1) * 16 + swz / 64; C = (st & 1) * 32 + (swz % 64) / 2; }
__device__ __forceinline__ int perm32(int rho) { const int n = rho >> 4, i = rho & 15; return 8 * (i >> 2) + 4 * n + (i & 3); }
struct Unit { int pm, pn; };
struct Gemm { const bf16_t* A; const bf16_t* Bt; int M, N, K; };
struct StaticOrder {
    int nM, nN, nwg, G, c;
    __device__ void init(int M, int N, int G_, int c_) { nM = M / BM; nN = N / BM; nwg = nM * nN; G = G_; c = c_; }
    __device__ bool next(int i, Unit& u) const {
        const long L = (long)i * G + c; if (L >= nwg) return false;
        int wgid = (int)L; { const int q = nwg / NXCD, r = nwg % NXCD, xcd = wgid % NXCD, off = wgid / NXCD; wgid = (xcd < r ? xcd * (q + 1) : r * (q + 1) + (xcd - r) * q) + off; }
        const int nig = WGM * nN, gid = wgid / nig, fm = gid * WGM, gsz = (nM - fm) < WGM ? (nM - fm) : WGM;
        u.pm = fm + ((wgid % nig) % gsz); u.pn = (wgid % nig) / gsz; return true;
    }
};

template <class Epi, class Sched>
__device__ __forceinline__ void gemm_phase(LAS unsigned char* lds, const Gemm g, const Sched& S, const Epi& E, const int wid) {
    const int lane = lane_fresh(), tid = wid * 64 + lane, wr = wid >> 2, wc = wid & 3, fr = lane & 15, fq = lane >> 4;
    const int K = g.K, nt = K / BK;
    unsigned voffA[2], voffB[2];
#pragma unroll
    for (int i = 0; i < 2; ++i) { int R, C; stage_rc(tid * 16 + i * 8192, R, C); const int Rb = 2 * (R & ~31) + perm32(R & 31);
        voffA[i] = (unsigned)(R * K + C) * 2u; voffB[i] = (unsigned)(Rb * K + C) * 2u; }
    const size_t kstep = (size_t)(BK * 2);
    const size_t hstep = (size_t)HALF * K * 2;
    const size_t tstep = 2 * hstep;
    const size_t bstep = (size_t)32 * K * 2;
    const unsigned ldsw = (unsigned)wid * 1024u;
    const int aoff = lds_byte(wr * 64 + fr, fq * 8), boff = lds_byte(wc * 32 + fr, fq * 8);
#define PG8_SA(b, h) (((b) * 2 + (h)) * HTB)
#define PG8_SB(b, h) ((4 + (b) * 2 + (h)) * HTB)
#define PG8_STAGE(bufoff, gbase, voff) do { _Pragma("unroll") for (int _i = 0; _i < 2; ++_i) \
        __builtin_amdgcn_global_load_lds((const unsigned*)((const char*)(gbase) + (voff)[_i]), (LAS unsigned*)(lds + (bufoff) + ldsw + _i * 8192), 16, 0, 0); } while (0)
#define PG8_LDA(dst, b, h) do { _Pragma("unroll") for (int m = 0; m < 4; ++m) _Pragma("unroll") for (int k = 0; k < 2; ++k) dst[m][k] = *(const LAS bf16x8*)(lds + PG8_SA(b, h) + aoff + m * 2048 + k * 1024); } while (0)
#define PG8_LDB(dst, b, h) do { _Pragma("unroll") for (int n = 0; n < 2; ++n) _Pragma("unroll") for (int k = 0; k < 2; ++k) dst[n][k] = *(const LAS bf16x8*)(lds + PG8_SB(b, h) + boff + n * 2048 + k * 1024); } while (0)
#define PG8_MMA(ai, bj, At, Bt) do { __builtin_amdgcn_s_setprio(1); _Pragma("unroll") for (int m = 0; m < 4; ++m) _Pragma("unroll") for (int n = 0; n < 2; ++n) _Pragma("unroll") for (int k = 0; k < 2; ++k) \
        acc[ai][bj][m][n] = __builtin_amdgcn_mfma_f32_16x16x32_bf16(Bt[n][k], At[m][k], acc[ai][bj][m][n], 0, 0, 0); __builtin_amdgcn_s_setprio(0); } while (0)
#define PG8_WAIT_V(n) asm volatile("s_waitcnt vmcnt(" #n ")" ::: "memory")
#define PG8_WAIT_L(n) asm volatile("s_waitcnt lgkmcnt(" #n ")" ::: "memory")
#define PG8_BAR __builtin_amdgcn_s_barrier()
#define PG8_SCHED __builtin_amdgcn_sched_barrier(0)
    Unit cur, nxt; int ui = 0;
    if (!S.next(0, cur)) return;
    f32x4 acc[2][2][4][2];
    if constexpr (Epi::INIT) E.init(acc, cur, 0, wr, wc, fr, fq);
    else {
#pragma unroll
    for (int a = 0; a < 2; ++a)
#pragma unroll
        for (int b = 0; b < 2; ++b)
#pragma unroll
            for (int m = 0; m < 4; ++m)
#pragma unroll
                for (int n = 0; n < 2; ++n) acc[a][b][m][n] = (f32x4){0.f, 0.f, 0.f, 0.f};
    }
    bf16x8 At[4][2], B0[2][2], B1[2][2];
    const char* cA = (const char*)g.A + (size_t)cur.pm * tstep; const char* cB = (const char*)g.Bt + (size_t)cur.pn * tstep;
    PG8_STAGE(PG8_SB(0, 0), cB, voffB); PG8_STAGE(PG8_SB(0, 1), cB + bstep, voffB); PG8_STAGE(PG8_SA(0, 0), cA, voffA); PG8_STAGE(PG8_SA(0, 1), cA + hstep, voffA);
    if (wr == 1) PG8_BAR;
    PG8_WAIT_V(2); PG8_BAR;
    PG8_STAGE(PG8_SB(1, 0), cB + kstep, voffB); PG8_STAGE(PG8_SA(1, 0), cA + kstep, voffA); PG8_STAGE(PG8_SB(1, 1), cB + bstep + kstep, voffB);
    PG8_WAIT_V(6); PG8_BAR;
    for (;;) {
        const bool has_next = S.next(ui + 1, nxt);
        const char* nA = has_next ? (const char*)g.A + (size_t)nxt.pm * tstep : cA; const char* nB = has_next ? (const char*)g.Bt + (size_t)nxt.pn * tstep : cB;
        for (int t = 0; t < nt; t += 2) {
            const bool last = (t == nt - 2);
            const char* a1 = cA + (size_t)(t + 1) * kstep;
            const char* a2 = last ? nA : cA + (size_t)(t + 2) * kstep; const char* b2 = last ? nB : cB + (size_t)(t + 2) * kstep;
            const char* a3 = a2 + kstep; const char* b3 = b2 + kstep;
            if constexpr (Epi::MID) { if (t == nt / 2) E.mid(acc, cur, ui, wr, wc, fr, fq); }
            PG8_LDB(B0, 0, 0); PG8_LDB(B1, 0, 1); PG8_SCHED; PG8_LDA(At, 0, 0); PG8_STAGE(PG8_SA(1, 1), a1 + hstep, voffA);
            PG8_WAIT_V(8); PG8_WAIT_L(0); PG8_BAR; PG8_MMA(0, 0, At, B0); PG8_MMA(0, 1, At, B1); PG8_BAR; PG8_SCHED;
            PG8_LDA(At, 0, 1); PG8_STAGE(PG8_SB(0, 0), b2, voffB); PG8_STAGE(PG8_SB(0, 1), b2 + bstep, voffB); PG8_STAGE(PG8_SA(0, 0), a2, voffA);
            PG8_WAIT_V(8); PG8_WAIT_L(0); PG8_BAR; PG8_MMA(1, 0, At, B0); PG8_MMA(1, 1, At, B1); PG8_BAR; PG8_SCHED;
            PG8_LDB(B0, 1, 0); PG8_LDB(B1, 1, 1); PG8_SCHED; PG8_LDA(At, 1, 0); PG8_STAGE(PG8_SA(0, 1), a2 + hstep, voffA);
            PG8_WAIT_V(8); PG8_WAIT_L(0); PG8_BAR; PG8_MMA(0, 0, At, B0); PG8_MMA(0, 1, At, B1); PG8_BAR; PG8_SCHED;
            PG8_LDA(At, 1, 1); PG8_STAGE(PG8_SB(1, 0), b3, voffB); PG8_STAGE(PG8_SB(1, 1), b3 + bstep, voffB); PG8_STAGE(PG8_SA(1, 0), a3, voffA);
            PG8_WAIT_V(8); PG8_WAIT_L(0); PG8_BAR; PG8_MMA(1, 0, At, B0); PG8_MMA(1, 1, At, B1); PG8_BAR; PG8_SCHED;
        }
        if (wr == 0) PG8_BAR;
        E(acc, cur, ui, wr, wc, fr, fq);
        if (!has_next) break;
        if constexpr (Epi::INIT) E.init(acc, nxt, ui + 1, wr, wc, fr, fq);
        else {
#pragma unroll
        for (int a = 0; a < 2; ++a)
#pragma unroll
            for (int b = 0; b < 2; ++b)
#pragma unroll
                for (int m = 0; m < 4; ++m)
#pragma unroll
                    for (int n = 0; n < 2; ++n) acc[a][b][m][n] = (f32x4){0.f, 0.f, 0.f, 0.f};
        }
        cur = nxt; cA = nA; cB = nB; ++ui;
        if (wr == 1) PG8_BAR;
    }
    PG8_WAIT_V(0);
    PG8_BAR;
#undef PG8_SA
#undef PG8_SB
#undef PG8_STAGE
#undef PG8_LDA
#undef PG8_LDB
#undef PG8_MMA
#undef PG8_WAIT_V
#undef PG8_WAIT_L
#undef PG8_BAR
#undef PG8_SCHED
}
}

struct EpiIn {
    static constexpr bool MID = false, INIT = false;
    bf16_t* P; const LAS float* rows; float* svg; float* knp; float* nvp; float* nks; float* nvs; LAS unsigned char* stg;
    template <int KIND>
    __device__ __forceinline__ void body(const f32x4 (&acc)[2][2][4][2], const pg8::Unit& u, int ui, int wr, int wc, int fr, int fq) const {
        const int row0 = u.pm * 256 + wr * 64 + fr;
        const int col0 = u.pn * 256 + wc * 64 + 8 * fq;
        const LAS float* rsl = rows + ui * 256 + wr * 64 + fr;
        const int sl = fq * 16 + fr, srow = sl >> 3, spc = sl & 7;
        LAS unsigned char* sw = stg ? stg + (wr * 4 + wc) * 2304 : nullptr;
#pragma unroll
        for (int ai = 0; ai < 2; ++ai)
#pragma unroll
            for (int m = 0; m < 4; ++m) {
                const int row = row0 + ai * 128 + m * 16;
                const float rs = rsl[ai * 128 + m * 16];
                bf16_t* rowp = P + (size_t)row * DPROJ + col0;
                float* dst = nullptr;
                if (KIND == 4) {
                    float* bp = (u.pn == 5) ? nvp : knp; float* bs = (u.pn == 5) ? nvs : nks;
                    if (u.pm < 128) { if ((u.pm & 7) == 7 && ai == 1) dst = bp + (size_t)((u.pm >> 3) * 128 + wr * 64 + m * 16 + fr) * 256 + wc * 64 + 8 * fq; }
                    else { const int sr = row - NP; dst = bs + (size_t)((sr >> 5) * 128 + 96 + (sr & 31)) * 256 + wc * 64 + 8 * fq; }
                }
                float s1 = 0.f, s2 = 0.f;
#pragma unroll
                for (int bj = 0; bj < 2; ++bj) {
                    f32x4 v0 = acc[ai][bj][m][0] * rs, v1 = acc[ai][bj][m][1] * rs;
                    if (KIND == 1) { v0 = silu4(v0); v1 = silu4(v1); }
                    if (KIND == 2 || KIND == 3) { v0 = gelu4(v0); v1 = gelu4(v1); }
                    if (KIND == 3) { s1 += (v0[0] + v0[1]) + (v0[2] + v0[3]) + (v1[0] + v1[1]) + (v1[2] + v1[3]);
                        s2 += (v0[0] * v0[0] + v0[1] * v0[1]) + (v0[2] * v0[2] + v0[3] * v0[3]) + (v1[0] * v1[0] + v1[1] * v1[1]) + (v1[2] * v1[2] + v1[3] * v1[3]); }
                    if (sw) *(LAS u32x4*)(sw + fr * 144 + bj * 64 + fq * 16) = pack8(v0, v1);
                    else *(u32x4*)(rowp + bj * 32) = pack8(v0, v1);
                    if (KIND == 4) { if (dst) { *(f32x4*)(dst + bj * 32) = v0; *(f32x4*)(dst + bj * 32 + 4) = v1; } }
                }
                if (sw) {
                    bf16_t* gb = P + (size_t)(u.pm * 256 + ai * 128 + wr * 64 + m * 16 + srow) * DPROJ + u.pn * 256 + wc * 64 + spc * 8;
                    const u32x4 w0 = *(const LAS u32x4*)(sw + srow * 144 + spc * 16), w1 = *(const LAS u32x4*)(sw + (srow + 8) * 144 + spc * 16);
                    *(u32x4*)gb = w0; *(u32x4*)(gb + (size_t)8 * DPROJ) = w1;
                }
                if (KIND == 3) {
                    s1 = fq_sum(s1); s2 = fq_sum(s2);
                    if (fq == 0) *(f32x2*)(svg + ((size_t)row * 16 + (u.pn - 14) * 4 + wc) * 2) = (f32x2){s1, s2};
                }
            }
    }
    __device__ __forceinline__ void operator()(const f32x4 (&acc)[2][2][4][2], const pg8::Unit& u, int ui, int wr, int wc, int fr, int fq) const {
        const int pn = u.pn;
        if (pn < 4) body<0>(acc, u, ui, wr, wc, fr, fq);
        else if (pn < 6) body<4>(acc, u, ui, wr, wc, fr, fq);
        else if (pn < 10 || pn >= 18) body<1>(acc, u, ui, wr, wc, fr, fq);
        else if (pn < 14) body<2>(acc, u, ui, wr, wc, fr, fq);
        else body<3>(acc, u, ui, wr, wc, fr, fq);
    }
};

struct EpiOut {
    static constexpr bool MID = true, INIT = true;
    float* out; bf16_t* xb; float* ssx; const LAS float* rows; int last;
    __device__ __forceinline__ void init(f32x4 (&acc)[2][2][4][2], const pg8::Unit& u, int ui, int wr, int wc, int fr, int fq) const {
        int row0 = u.pm * 256 + wr * 64 + fr;
        asm volatile("" : "+v"(row0));
        const int col0 = u.pn * 256 + wc * 64 + 8 * fq;
        const LAS float* rl = rows + ui * 768 + ((row0 - u.pm * 256));
#pragma unroll
        for (int ai = 0; ai < 2; ++ai)
#pragma unroll
            for (int m = 0; m < 4; ++m) {
                const int row = row0 + ai * 128 + m * 16;
                const bf16_t* base = xb + (size_t)row * DM + col0;
#pragma unroll
                for (int bj = 0; bj < 2; ++bj) { const u32x4 w = *(const u32x4*)(base + bj * 32);
                    acc[ai][bj][m][0] = (f32x4){bf_lo(w.x), bf_hi(w.x), bf_lo(w.y), bf_hi(w.y)}; acc[ai][bj][m][1] = (f32x4){bf_lo(w.z), bf_hi(w.z), bf_lo(w.w), bf_hi(w.w)}; }
            }
#pragma unroll
        for (int ai = 0; ai < 2; ++ai)
#pragma unroll
            for (int m = 0; m < 4; ++m) {
                const float ia = rl[ai * 128 + m * 16];
#pragma unroll
                for (int bj = 0; bj < 2; ++bj)
#pragma unroll
                    for (int n = 0; n < 2; ++n) acc[ai][bj][m][n] = acc[ai][bj][m][n] * ia;
            }
    }
    __device__ __forceinline__ void mid(f32x4 (&acc)[2][2][4][2], const pg8::Unit& u, int ui, int wr, int wc, int fr, int fq) const {
        int rt = wr * 64 + fr;
        asm volatile("" : "+v"(rt));
        const LAS float* rl = rows + ui * 768 + 256 + rt;
#pragma unroll
        for (int ai = 0; ai < 2; ++ai)
#pragma unroll
            for (int m = 0; m < 4; ++m) {
                const float ratio = rl[ai * 128 + m * 16];
#pragma unroll
                for (int bj = 0; bj < 2; ++bj)
#pragma unroll
                    for (int n = 0; n < 2; ++n) acc[ai][bj][m][n] = acc[ai][bj][m][n] * ratio;
            }
    }
    __device__ __forceinline__ void operator()(const f32x4 (&acc)[2][2][4][2], const pg8::Unit& u, int ui, int wr, int wc, int fr, int fq) const {
        const int row0 = u.pm * 256 + wr * 64 + fr;
        const int col0 = u.pn * 256 + wc * 64 + 8 * fq;
        const LAS float* rl = rows + ui * 768 + 512 + wr * 64 + fr;
#pragma unroll
        for (int ai = 0; ai < 2; ++ai)
#pragma unroll
            for (int m = 0; m < 4; ++m) {
                const int row = row0 + ai * 128 + m * 16;
                const float rb = rl[ai * 128 + m * 16];
                float* o = out + (size_t)row * DM + col0; bf16_t* xo = xb + (size_t)row * DM + col0;
                float ss = 0.f;
#pragma unroll
                for (int bj = 0; bj < 2; ++bj) {
                    const f32x4 v0 = acc[ai][bj][m][0] * rb, v1 = acc[ai][bj][m][1] * rb;
                    if (last) { *(f32x4*)(o + bj * 32) = v0; *(f32x4*)(o + bj * 32 + 4) = v1; }
                    else *(u32x4*)(xo + bj * 32) = pack8(v0, v1);
                    ss += (v0[0] * v0[0] + v0[1] * v0[1]) + (v0[2] * v0[2] + v0[3] * v0[3]) + (v1[0] * v1[0] + v1[1] * v1[1]) + (v1[2] * v1[2] + v1[3] * v1[3]);
                }
                ss = fq_sum(ss);
                if (fq == 0) ssx[(size_t)row * 32 + u.pn * 4 + wc] = ss;
                asm volatile("" ::: "memory");
            }
    }
};

struct TItem { const float* W; const float* gk; bf16_t* WT; int N, k0, n0; };
__device__ __forceinline__ TItem p0_item(const Params& p, bf16_t* WIN, bf16_t* WOUT, int it) {
    constexpr int I_IN = (DM / 64) * (DPROJ / 32), I_OUT = (DM / 64) * (DM / 32), I_L = I_IN + I_OUT;
    const int l = it / I_L; int r = it - l * I_L; TItem t;
    if (r < I_IN) { const int nblk = DPROJ / 32, kb = r / nblk; t.k0 = 64 * kb; t.n0 = 32 * (r - kb * nblk); t.N = DPROJ; t.W = p.w_in + (size_t)l * DM * DPROJ; t.gk = p.norm_in + l * DM + t.k0; t.WT = WIN + (size_t)l * DPROJ * DM; }
    else { r -= I_IN; const int nblk = DM / 32, kb = r / nblk; t.k0 = 64 * kb; t.n0 = 32 * (r - kb * nblk); t.N = DM; t.W = p.w_out + (size_t)l * DM * DM;
        t.gk = (t.k0 < 1024) ? p.norm_attn + l * 1024 + t.k0 : p.norm_gmlp + l * 1024 + (t.k0 - 1024); t.WT = WOUT + (size_t)l * DM * DM; }
    return t;
}
__device__ __forceinline__ void p0_load(const TItem& t, f32x4 (&v)[8], int lane) {
#pragma unroll
    for (int i = 0; i < 8; ++i) { const int kk = 8 * i + (lane >> 3); v[i] = *(const f32x4*)(t.W + (size_t)(t.k0 + kk) * t.N + t.n0 + 4 * (lane & 7)) * t.gk[kk]; }
}
__device__ __forceinline__ void p0_emit(const TItem& t, const f32x4 (&v)[8], LAS float* scr, int lane) {
#pragma unroll
    for (int i = 0; i < 8; ++i) { LAS float* d = scr + (8 * i + (lane >> 3)) * 33 + 4 * (lane & 7); d[0] = v[i][0]; d[1] = v[i][1]; d[2] = v[i][2]; d[3] = v[i][3]; }
    asm volatile("s_waitcnt lgkmcnt(0)" ::: "memory");
    const int c = lane & 7;
#pragma unroll
    for (int j = 0; j < 4; ++j) { const int n = (lane >> 3) + 8 * j; const LAS float* sp = scr + (8 * c) * 33 + n;
        u32x4 o; o.x = pk2(sp[0 * 33], sp[1 * 33]); o.y = pk2(sp[2 * 33], sp[3 * 33]); o.z = pk2(sp[4 * 33], sp[5 * 33]); o.w = pk2(sp[6 * 33], sp[7 * 33]);
        *(u32x4*)(t.WT + (size_t)(t.n0 + n) * DM + t.k0 + 8 * c) = o; }
    asm volatile("s_waitcnt lgkmcnt(0)" ::: "memory");
}

__device__ __forceinline__ void prologue(LAS unsigned char* lds, const Params& p, int tid, int wave, int lane, int bid, int G) {
    lane = lane_fresh(); tid = wave * 64 + lane;
    unsigned char* ws = p.ws;
    bf16_t* WIN = (bf16_t*)(ws + WS_WIN); bf16_t* WOUT = (bf16_t*)(ws + WS_WOUT); bf16_t* XB = (bf16_t*)(ws + WS_XB);
    float* SSX = (float*)(ws + WS_SSX);
    LAS float* scr = (LAS float*)(lds + wave * 17408);
    const int gw = bid * 8 + wave, NGW = G * 8;
    constexpr int NIT = DEPTH * ((DM / 64) * (DPROJ / 32) + (DM / 64) * (DM / 32));
    for (int it = gw; it < NIT; it += 2 * NGW) {
        const bool two = it + NGW < NIT;
        const TItem ta = p0_item(p, WIN, WOUT, it), tb = p0_item(p, WIN, WOUT, two ? it + NGW : it);
        f32x4 va[8], vb[8];
        p0_load(ta, va, lane); if (two) p0_load(tb, vb, lane);
        p0_emit(ta, va, scr, lane); if (two) p0_emit(tb, vb, scr + 64 * 33, lane);
    }
    for (int row = gw; row < MT; row += 2 * NGW) {
        const int row2 = row + NGW; const bool two = row2 < MT; const int rb = two ? row2 : row;
        const f32x4* xa = (const f32x4*)(row < NP ? p.x_prompt + (size_t)row * DM : p.x_sample + (size_t)(row - NP) * DM) + lane;
        const f32x4* xb2 = (const f32x4*)(rb < NP ? p.x_prompt + (size_t)rb * DM : p.x_sample + (size_t)(rb - NP) * DM) + lane;
        f32x4 va[8], vb[8];
#pragma unroll
        for (int j = 0; j < 8; ++j) va[j] = xa[64 * j];
#pragma unroll
        for (int j = 0; j < 8; ++j) vb[j] = xb2[64 * j];
        u32x2* oa = (u32x2*)(XB + (size_t)row * DM) + lane; u32x2* ob = (u32x2*)(XB + (size_t)rb * DM) + lane;
        float sa = 0.f, sb = 0.f;
#pragma unroll
        for (int j = 0; j < 8; ++j) { const f32x4 v = va[j]; sa += (v[0] * v[0] + v[1] * v[1]) + (v[2] * v[2] + v[3] * v[3]); u32x2 w; w.x = pk2(v[0], v[1]); w.y = pk2(v[2], v[3]); oa[64 * j] = w; }
        if (two) {
#pragma unroll
            for (int j = 0; j < 8; ++j) { const f32x4 v = vb[j]; sb += (v[0] * v[0] + v[1] * v[1]) + (v[2] * v[2] + v[3] * v[3]); u32x2 w; w.x = pk2(v[0], v[1]); w.y = pk2(v[2], v[3]); ob[64 * j] = w; }
        }
        sa = wave_sum(sa); sb = wave_sum(sb);
        if (lane < 32) { SSX[(size_t)row * 32 + lane] = (lane == 0) ? sa : 0.f; if (two) SSX[(size_t)row2 * 32 + lane] = (lane == 0) ? sb : 0.f; }
    }
    for (int seg = bid; seg < 256; seg += G) {
        const int kv = seg >> 7, lb = seg & 127;
        const f32x4* src = (const f32x4*)((kv ? p.cache_v : p.cache_k) + ((size_t)lb * 128 + 32) * 256);
        f32x4* dst = (f32x4*)(p.out + (kv ? OUT_NVS : OUT_NKS) + (size_t)lb * 128 * 256);
        for (int i = tid; i < 96 * 64; i += 512) dst[i] = src[i];
    }
}

constexpr int L_KS = 0, L_VT = 27648, L_WS = 73728, L_MUR = 108544, L_BIAS = 131072;
#define MFMA32(a, b, c) __builtin_amdgcn_mfma_f32_32x32x16_bf16((a), (b), (c), 0, 0, 0)
__device__ __forceinline__ bf16x8 pack_step(const f32x16& x, int s) {
    u32x4 w; w.x = pk2(x[8 * s], x[8 * s + 1]); w.y = pk2(x[8 * s + 2], x[8 * s + 3]); w.z = pk2(x[8 * s + 4], x[8 * s + 5]); w.w = pk2(x[8 * s + 6], x[8 * s + 7]);
    return __builtin_bit_cast(bf16x8, w);
}

__device__ __forceinline__ void attn_task(LAS unsigned char* lds, const Params& p, const bf16_t* P, bf16_t* Y, float* ssa, int l, bool sample, int b, int c, int kvh, int tid, int wave, int lane) {
    lane = lane_fresh(); tid = wave * 64 + lane;
    LAS bf16_t* KS = (LAS bf16_t*)(lds + L_KS);
    LAS bf16_t* VT = (LAS bf16_t*)(lds + L_VT);
    const LAS float* BIAS = (const LAS float*)(lds + L_BIAS);
    const int nk = sample ? 160 : 192;
    const int jmin = sample ? 0 : (c >= 2 ? 0 : (2 - c) * 64);
    for (int id = tid; id < nk * 8; id += 512) {
        const int j = id >> 3, ch = id & 7;
        if (j >= jmin) {
            u32x4 w;
            if (sample && j < 128) { const float* src = p.cache_k + ((((size_t)l * 32 + b) * 128 + j) * 4 + kvh) * 64 + ch * 8; w = pack8(*(const f32x4*)src, *(const f32x4*)(src + 4)); }
            else { const size_t row = sample ? (size_t)NP + b * 32 + (j - 128) : (size_t)b * 2048 + (c - 2) * 64 + j; w = *(const u32x4*)(P + row * DPROJ + O_K + kvh * 64 + ch * 8); }
            *(LAS u32x4*)(KS + j * 72 + ch * 8) = w;
        }
    }
    for (int id = tid; id < nk * 8; id += 512) {
        const int ch = id / nk, j = id - ch * nk;
        if (j >= jmin) {
            u32x4 w;
            if (sample && j < 128) { const float* src = p.cache_v + ((((size_t)l * 32 + b) * 128 + j) * 4 + kvh) * 64 + ch * 8; w = pack8(*(const f32x4*)src, *(const f32x4*)(src + 4)); }
            else { const size_t row = sample ? (size_t)NP + b * 32 + (j - 128) : (size_t)b * 2048 + (c - 2) * 64 + j; w = *(const u32x4*)(P + row * DPROJ + O_V + kvh * 64 + ch * 8); }
#pragma unroll
            for (int e = 0; e < 4; ++e) { VT[(ch * 8 + 2 * e) * 200 + j] = (bf16_t)(w[e] & 0xffffu); VT[(ch * 8 + 2 * e + 1) * 200 + j] = (bf16_t)(w[e] >> 16); }
        }
    }
    __syncthreads();
    const int r = lane & 31, h = lane >> 5;
    const bool active = sample ? (wave < 4) : true;
    if (active) {
        const int g = sample ? wave : (wave >> 1), qh = sample ? 0 : (wave & 1);
        const int head = kvh * 4 + g, i = 32 * qh + r;
        const size_t qrow = sample ? (size_t)NP + b * 32 + i : (size_t)b * 2048 + c * 64 + i;
        bf16x8 qf[4];
#pragma unroll
        for (int s = 0; s < 4; ++s) qf[s] = *(const bf16x8*)(P + qrow * DPROJ + O_Q + head * 64 + 16 * s + 8 * h);
        const bf16_t* gp = P + qrow * DPROJ + O_GA + head * 64 + 8 * h;
        u32x4 gwv[4];
#pragma unroll
        for (int e = 0; e < 4; ++e) gwv[e] = *(const u32x4*)(gp + 16 * e);
        const int T0 = jmin >> 5, NT = nk >> 5;
        f32x16 st[6];
#pragma unroll
        for (int T = 0; T < 6; ++T) {
            f32x16 acc;
            if (T >= T0 && T < NT) {
#pragma unroll
                for (int e = 0; e < 16; ++e) acc[e] = 0.f;
#pragma unroll
                for (int s = 0; s < 4; ++s) { const bf16x8 a = *(const LAS bf16x8*)(KS + (32 * T + r) * 72 + 16 * s + 8 * h); acc = MFMA32(a, qf[s], acc); }
            } else {
#pragma unroll
                for (int e = 0; e < 16; ++e) acc[e] = -1e30f;
            }
            st[T] = acc;
        }
        const float sc = 0.125f * LOG2E;
        const LAS float* bl = BIAS + head * 256 + 63 - i + 4 * h;
        float mx = -3e38f;
#pragma unroll
        for (int T = 0; T < 6; ++T)
            if (T >= T0 && T < NT) {
#pragma unroll
                for (int e = 0; e < 16; ++e) { const float v = st[T][e] * sc + bl[32 * T + (e & 3) + 8 * (e >> 2)]; st[T][e] = v; mx = fmaxf(mx, v); }
                }
        mx = fmaxf(mx, __shfl_xor(mx, 32));
        const float sink2 = p.sinks[l * 16 + head] * LOG2E;
        mx = fmaxf(mx, sink2);
        float sum = 0.f;
#pragma unroll
        for (int T = 0; T < 6; ++T)
#pragma unroll
            for (int e = 0; e < 16; ++e) { const float pv = __builtin_amdgcn_exp2f(st[T][e] - mx); st[T][e] = pv; sum += pv; }
        sum += __shfl_xor(sum, 32);
        sum += __builtin_amdgcn_exp2f(sink2 - mx);
        const float inv = 1.0f / sum;
        f32x16 o[2];
#pragma unroll
        for (int e = 0; e < 16; ++e) { o[0][e] = 0.f; o[1][e] = 0.f; }
#pragma unroll
        for (int T = 0; T < 6; ++T)
            if (T >= T0 && T < NT) {
#pragma unroll
                for (int s = 0; s < 2; ++s) {
                    const bf16x8 xs = pack_step(st[T], s);
#pragma unroll
                    for (int dt = 0; dt < 2; ++dt) {
                        const LAS bf16_t* vp = VT + (32 * dt + r) * 200 + 32 * T + 16 * s + 4 * h;
                        const s16x4 lo = *(const LAS s16x4*)vp, hi = *(const LAS s16x4*)(vp + 8);
                        const bf16x8 pa = __builtin_shufflevector(lo, hi, 0, 1, 2, 3, 4, 5, 6, 7);
                        o[dt] = MFMA32(pa, xs, o[dt]);
                    }
                }
                }
        float ss = 0.f;
        bf16_t* yp = Y + qrow * DM + head * 64 + 8 * h;
#pragma unroll
        for (int dt = 0; dt < 2; ++dt)
#pragma unroll
            for (int pr = 0; pr < 2; ++pr) {
                float a[4], bq[4];
#pragma unroll
                for (int k = 0; k < 4; ++k) { a[k] = o[dt][8 * pr + k] * inv; bq[k] = o[dt][8 * pr + 4 + k] * inv; }
                ss += ((a[0] * a[0] + a[1] * a[1]) + (a[2] * a[2] + a[3] * a[3])) + ((bq[0] * bq[0] + bq[1] * bq[1]) + (bq[2] * bq[2] + bq[3] * bq[3]));
#pragma unroll
                for (int k = 0; k < 4; ++k) swap_halves(a[k], bq[k]);
                const u32x4 gw = gwv[2 * dt + pr];
                u32x4 w; w.x = pk2(a[0] * bf_lo(gw.x), a[1] * bf_hi(gw.x)); w.y = pk2(a[2] * bf_lo(gw.y), a[3] * bf_hi(gw.y));
                w.z = pk2(bq[0] * bf_lo(gw.z), bq[1] * bf_hi(gw.z)); w.w = pk2(bq[2] * bf_lo(gw.w), bq[3] * bf_hi(gw.w));
                *(u32x4*)(yp + 32 * dt + 16 * pr) = w;
            }
        ss += __shfl_xor(ss, 32);
        if (h == 0) ssa[qrow * 16 + head] = ss;
    }
    __syncthreads();
}

__device__ __forceinline__ void attn_run(LAS unsigned char* lds, const Params& p, const bf16_t* P, bf16_t* Y, float* ssa, int l, int t0, int t1, int wave) {
    if (t0 >= t1) return;
    const int lane = lane_fresh(), tid = wave * 64 + lane;
    LAS bf16_t* KS = (LAS bf16_t*)(lds + L_KS);
    LAS bf16_t* VT = (LAS bf16_t*)(lds + L_VT);
    const LAS float* BIAS = (const LAS float*)(lds + L_BIAS);
    const int r = lane & 31, h = lane >> 5;
    const int jk = tid >> 3, chk = tid & 7;
    const int jv = tid & 63, chv = tid >> 6;
    u32x4 pk = (u32x4){0u, 0u, 0u, 0u}, pv = pk;
    bf16x8 qn[4];
#pragma unroll
    for (int s = 0; s < 4; ++s) qn[s] = (bf16x8){0, 0, 0, 0, 0, 0, 0, 0};
    int prev_bk = -1, prev_c = -100;
    for (int t = t0; t < t1; ++t) {
        const int c = t & 31, bk = t >> 5, kvh = bk & 3, b = bk >> 2;
        const bool cont = (bk == prev_bk) && (c == prev_c + 1);
        const bf16_t* Pk = P + ((size_t)b * 2048 + jk) * DPROJ + O_K + kvh * 64 + chk * 8;
        const bf16_t* Pv = P + ((size_t)b * 2048 + jv) * DPROJ + O_V + kvh * 64 + chv * 8;
        if (cont) {
            const int slot = c % 3;
            *(LAS u32x4*)(KS + (slot * 64 + jk) * 72 + chk * 8) = pk;
#pragma unroll
            for (int e = 0; e < 4; ++e) { VT[(chv * 8 + 2 * e) * 200 + slot * 64 + jv] = (bf16_t)(pv[e] & 0xffffu); VT[(chv * 8 + 2 * e + 1) * 200 + slot * 64 + jv] = (bf16_t)(pv[e] >> 16); }
        } else {
            for (int q = (c >= 2 ? c - 2 : 0); q <= c; ++q) {
                const int slot = q % 3;
                const u32x4 wk = *(const u32x4*)(Pk + (size_t)q * 64 * DPROJ), wv = *(const u32x4*)(Pv + (size_t)q * 64 * DPROJ);
                *(LAS u32x4*)(KS + (slot * 64 + jk) * 72 + chk * 8) = wk;
#pragma unroll
                for (int e = 0; e < 4; ++e) { VT[(chv * 8 + 2 * e) * 200 + slot * 64 + jv] = (bf16_t)(wv[e] & 0xffffu); VT[(chv * 8 + 2 * e + 1) * 200 + slot * 64 + jv] = (bf16_t)(wv[e] >> 16); }
            }
        }
        __syncthreads();
        {
            const int g = wave >> 1, qh = wave & 1;
            const int head = kvh * 4 + g, i = 32 * qh + r;
            const size_t qrow = (size_t)b * 2048 + c * 64 + i;
            const bf16_t* qp = P + qrow * DPROJ + O_Q + head * 64 + 8 * h;
            bf16x8 qf[4];
            if (cont) {
#pragma unroll
                for (int s = 0; s < 4; ++s) qf[s] = qn[s];
            } else {
#pragma unroll
                for (int s = 0; s < 4; ++s) qf[s] = *(const bf16x8*)(qp + 16 * s);
            }
            if (t + 1 < t1 && ((t + 1) >> 5) == bk) {
                pk = *(const u32x4*)(Pk + (size_t)(c + 1) * 64 * DPROJ); pv = *(const u32x4*)(Pv + (size_t)(c + 1) * 64 * DPROJ);
#pragma unroll
                for (int s = 0; s < 4; ++s) qn[s] = *(const bf16x8*)(qp + (size_t)64 * DPROJ + 16 * s);
            }
            const bf16_t* gp = P + qrow * DPROJ + O_GA + head * 64 + 8 * h;
            u32x4 gwv[4];
#pragma unroll
            for (int e = 0; e < 4; ++e) gwv[e] = *(const u32x4*)(gp + 16 * e);
            const int T0 = c >= 2 ? 0 : 2 * (2 - c);
            const int sl0 = (c + 1) % 3, sl1 = (c + 2) % 3, sl2 = c % 3;
            f32x16 st[6];
#pragma unroll
            for (int T = 0; T < 6; ++T) {
                f32x16 acc;
                const int prow = 64 * ((T >> 1) == 0 ? sl0 : ((T >> 1) == 1 ? sl1 : sl2)) + 32 * (T & 1);
                if (T >= T0) {
#pragma unroll
                    for (int e = 0; e < 16; ++e) acc[e] = 0.f;
#pragma unroll
                    for (int s = 0; s < 4; ++s) { const bf16x8 a = *(const LAS bf16x8*)(KS + (prow + r) * 72 + 16 * s + 8 * h); acc = MFMA32(a, qf[s], acc); }
                } else {
#pragma unroll
                    for (int e = 0; e < 16; ++e) acc[e] = -1e30f;
                }
                st[T] = acc;
            }
            const float sc = 0.125f * LOG2E;
            const LAS float* bl = BIAS + head * 256 + 63 - i + 4 * h;
            float mx = -3e38f;
#pragma unroll
            for (int T = 0; T < 6; ++T)
                if (T >= T0) {
#pragma unroll
                    for (int e = 0; e < 16; ++e) { const float v = st[T][e] * sc + bl[32 * T + (e & 3) + 8 * (e >> 2)]; st[T][e] = v; mx = fmaxf(mx, v); }
                }
            mx = fmaxf(mx, __shfl_xor(mx, 32));
            const float sink2 = p.sinks[l * 16 + head] * LOG2E;
            mx = fmaxf(mx, sink2);
            float sum = 0.f;
#pragma unroll
            for (int T = 0; T < 6; ++T)
#pragma unroll
                for (int e = 0; e < 16; ++e) { const float pe = __builtin_amdgcn_exp2f(st[T][e] - mx); st[T][e] = pe; sum += pe; }
            sum += __shfl_xor(sum, 32);
            sum += __builtin_amdgcn_exp2f(sink2 - mx);
            const float inv = 1.0f / sum;
            f32x16 o[2];
#pragma unroll
            for (int e = 0; e < 16; ++e) { o[0][e] = 0.f; o[1][e] = 0.f; }
#pragma unroll
            for (int T = 0; T < 6; ++T)
                if (T >= T0) {
                    const int prow = 64 * ((T >> 1) == 0 ? sl0 : ((T >> 1) == 1 ? sl1 : sl2)) + 32 * (T & 1);
#pragma unroll
                    for (int s = 0; s < 2; ++s) {
                        const bf16x8 xs = pack_step(st[T], s);
#pragma unroll
                        for (int dt = 0; dt < 2; ++dt) {
                            const LAS bf16_t* vp = VT + (32 * dt + r) * 200 + prow + 16 * s + 4 * h;
                            const s16x4 lo = *(const LAS s16x4*)vp, hi = *(const LAS s16x4*)(vp + 8);
                            const bf16x8 pa = __builtin_shufflevector(lo, hi, 0, 1, 2, 3, 4, 5, 6, 7);
                            o[dt] = MFMA32(pa, xs, o[dt]);
                        }
                    }
                }
            float ss = 0.f;
            bf16_t* yp = Y + qrow * DM + head * 64 + 8 * h;
#pragma unroll
            for (int dt = 0; dt < 2; ++dt)
#pragma unroll
                for (int pr = 0; pr < 2; ++pr) {
                    float a[4], bq[4];
#pragma unroll
                    for (int k = 0; k < 4; ++k) { a[k] = o[dt][8 * pr + k] * inv; bq[k] = o[dt][8 * pr + 4 + k] * inv; }
                    ss += ((a[0] * a[0] + a[1] * a[1]) + (a[2] * a[2] + a[3] * a[3])) + ((bq[0] * bq[0] + bq[1] * bq[1]) + (bq[2] * bq[2] + bq[3] * bq[3]));
#pragma unroll
                    for (int k = 0; k < 4; ++k) swap_halves(a[k], bq[k]);
                    const u32x4 gw = gwv[2 * dt + pr];
                    u32x4 w; w.x = pk2(a[0] * bf_lo(gw.x), a[1] * bf_hi(gw.x)); w.y = pk2(a[2] * bf_lo(gw.y), a[3] * bf_hi(gw.y));
                    w.z = pk2(bq[0] * bf_lo(gw.z), bq[1] * bf_hi(gw.z)); w.w = pk2(bq[2] * bf_lo(gw.w), bq[3] * bf_hi(gw.w));
                    *(u32x4*)(yp + 32 * dt + 16 * pr) = w;
                }
            ss += __shfl_xor(ss, 32);
            if (h == 0) ssa[qrow * 16 + head] = ss;
        }
        __syncthreads();
        prev_bk = bk; prev_c = c;
    }
}

__device__ __forceinline__ int vgt_off(int sidx) { return sidx * 18432; }
__device__ __forceinline__ void gmlp_task(LAS unsigned char* lds, const Params& p, const bf16_t* P, bf16_t* Y, const float* svg, float* ssb, int l, bool sample, int b, int g, int q, int tid, int wave, int lane, bool load_ws = true) {
    lane = lane_fresh(); tid = wave * 64 + lane;
    LAS bf16_t* WSL = (LAS bf16_t*)(lds + L_WS);
    LAS f32x2* MUR = (LAS f32x2*)(lds + L_MUR);
    if (load_ws) {
        const float* wsp = p.w_spatial + (size_t)(l * 16 + g) * 128 * 128;
#pragma unroll
        for (int k = 0; k < 4; ++k) {
            const int id = tid + 512 * k, i = id >> 4, j0 = (id & 15) * 8;
            f32x4 a = *(const f32x4*)(wsp + i * 128 + j0), bb = *(const f32x4*)(wsp + i * 128 + j0 + 4);
#pragma unroll
            for (int e = 0; e < 4; ++e) { if (j0 + e > i) a[e] = 0.f; if (j0 + 4 + e > i) bb[e] = 0.f; }
            *(LAS u32x4*)(WSL + i * 136 + j0) = pack8(a, bb);
        }
    }
    const int L = sample ? 32 : 128;
    const int r = lane & 31, h = lane >> 5;
    const float* lg = p.ln_v_g + l * 1024 + g * 64; const float* lb = p.ln_v_b + l * 1024 + g * 64;
    u32x4 wraw[4][2];
#pragma unroll
    for (int sub = 0; sub < 4; ++sub) {
        const int cidx = q * 4 + sub;
        const size_t row0 = sample ? (size_t)NP + cidx * 32 : (size_t)b * 2048 + cidx * 128;
#pragma unroll
        for (int k = 0; k < 2; ++k) {
            const int id = tid + 512 * k;
            if (id < L * 8) { const int ch = id & 7, j = id >> 3; wraw[sub][k] = *(const u32x4*)(P + (row0 + j) * DPROJ + O_VG + g * 64 + ch * 8); }
            else wraw[sub][k] = (u32x4){0u, 0u, 0u, 0u};
        }
    }
#pragma unroll
    for (int sub = 0; sub < 4; ++sub) {
        const int cidx = q * 4 + sub;
        const size_t row0 = sample ? (size_t)NP + cidx * 32 : (size_t)b * 2048 + cidx * 128;
        if ((tid >> 2) < L) {
            const int j = tid >> 2, qq = tid & 3;
            const f32x4* sp = (const f32x4*)(svg + ((row0 + j) * 16 + qq * 4) * 2);
            const f32x4 a = sp[0], bq = sp[1];
            float s1 = (a[0] + a[2]) + (bq[0] + bq[2]), s2 = (a[1] + a[3]) + (bq[1] + bq[3]);
            s1 += __shfl_xor(s1, 1); s1 += __shfl_xor(s1, 2); s2 += __shfl_xor(s2, 1); s2 += __shfl_xor(s2, 2);
            const float mean = s1 * (1.0f / 1024.0f), var = s2 * (1.0f / 1024.0f) - mean * mean;
            if (qq == 0) MUR[sub * 128 + j] = (f32x2){mean, __builtin_amdgcn_rsqf(var + EPS)};
        }
    }
    __syncthreads();
#pragma unroll
    for (int sub = 0; sub < 4; ++sub) {
        const int cidx = q * 4 + sub;
        const size_t row0 = sample ? (size_t)NP + cidx * 32 : (size_t)b * 2048 + cidx * 128;
        LAS bf16_t* VGT = (LAS bf16_t*)(lds + vgt_off(sub));
#pragma unroll
        for (int k = 0; k < 2; ++k) {
            const int id = tid + 512 * k;
            if (id >= L * 8) continue;
            const int ch = id & 7, j = id >> 3;
            const f32x2 mr = MUR[sub * 128 + j];
            const float mean = mr.x, rstd = mr.y;
            const u32x4 w = wraw[sub][k];
            const f32x4 g0 = *(const f32x4*)(lg + ch * 8), g1 = *(const f32x4*)(lg + ch * 8 + 4), b0 = *(const f32x4*)(lb + ch * 8), b1 = *(const f32x4*)(lb + ch * 8 + 4);
            f32x4 v0 = (f32x4){bf_lo(w.x), bf_hi(w.x), bf_lo(w.y), bf_hi(w.y)}, v1 = (f32x4){bf_lo(w.z), bf_hi(w.z), bf_lo(w.w), bf_hi(w.w)};
            v0 = (v0 - mean) * rstd * g0 + b0; v1 = (v1 - mean) * rstd * g1 + b1;
            if (sample) { float* dst = p.out + OUT_VGS + ((((size_t)l * 32 + cidx) * 32 + j) * 16 + g) * 64 + ch * 8; *(f32x4*)dst = v0; *(f32x4*)(dst + 4) = v1; }
            *(LAS u32x4*)(VGT + j * 72 + ch * 8) = pack8(v0, v1);
        }
    }
    __syncthreads();
    const int it = sample ? 0 : (wave >> 1), dt = wave & 1;
    const bool active = sample ? (wave < 2) : true;
    if (active) {
        const int i = 32 * it + r;
        const float bias = p.b_spatial[(l * 16 + g) * 128 + i];
        const int nks = 2 * (it + 1);
#pragma unroll
        for (int sub = 0; sub < 4; ++sub) {
            const int cidx = q * 4 + sub;
            const size_t row0 = sample ? (size_t)NP + cidx * 32 : (size_t)b * 2048 + cidx * 128;
            const LAS bf16_t* VGT = (const LAS bf16_t*)(lds + vgt_off(sub));
            const size_t row = row0 + i;
            const bf16_t* up = P + row * DPROJ + O_U + g * 64 + 32 * dt + 8 * h;
            const bf16_t* gp = P + row * DPROJ + O_GB + g * 64 + 32 * dt + 8 * h;
            u32x4 uw[2], gw[2];
#pragma unroll
            for (int pr = 0; pr < 2; ++pr) { uw[pr] = *(const u32x4*)(up + 16 * pr); gw[pr] = *(const u32x4*)(gp + 16 * pr); }
            f32x16 acc;
#pragma unroll
            for (int e = 0; e < 16; ++e) acc[e] = 0.f;
            const LAS bf16_t* tr = VGT + (8 * h + ((lane & 15) >> 2)) * 72 + 32 * dt + 16 * ((lane >> 4) & 1) + 4 * (lane & 3);
            for (int ks = 0; ks < nks; ++ks) {
                const s16x4 alo = __builtin_amdgcn_ds_read_tr16_b64_v4i16((LAS s16x4*)(tr + 16 * ks * 72)), ahi = __builtin_amdgcn_ds_read_tr16_b64_v4i16((LAS s16x4*)(tr + (16 * ks + 4) * 72));
                const bf16x8 a = __builtin_shufflevector(alo, ahi, 0, 1, 2, 3, 4, 5, 6, 7);
                const bf16x8 bw = *(const LAS bf16x8*)(WSL + (32 * it + r) * 136 + 16 * ks + 8 * h);
                acc = MFMA32(a, bw, acc);
            }
            bf16_t* yp = Y + row * DM + 1024 + g * 64 + 32 * dt + 8 * h;
            float ss = 0.f;
#pragma unroll
            for (int pr = 0; pr < 2; ++pr) {
                float a[4], bq[4];
#pragma unroll
                for (int k = 0; k < 4; ++k) { a[k] = acc[8 * pr + k] + bias; bq[k] = acc[8 * pr + 4 + k] + bias; }
#pragma unroll
                for (int k = 0; k < 4; ++k) swap_halves(a[k], bq[k]);
                const u32x4 u4 = uw[pr], g4 = gw[pr];
                a[0] *= bf_lo(u4.x); a[1] *= bf_hi(u4.x); a[2] *= bf_lo(u4.y); a[3] *= bf_hi(u4.y); bq[0] *= bf_lo(u4.z); bq[1] *= bf_hi(u4.z); bq[2] *= bf_lo(u4.w); bq[3] *= bf_hi(u4.w);
                ss += ((a[0] * a[0] + a[1] * a[1]) + (a[2] * a[2] + a[3] * a[3])) + ((bq[0] * bq[0] + bq[1] * bq[1]) + (bq[2] * bq[2] + bq[3] * bq[3]));
                u32x4 w; w.x = pk2(a[0] * bf_lo(g4.x), a[1] * bf_hi(g4.x)); w.y = pk2(a[2] * bf_lo(g4.y), a[3] * bf_hi(g4.y));
                w.z = pk2(bq[0] * bf_lo(g4.z), bq[1] * bf_hi(g4.z)); w.w = pk2(bq[2] * bf_lo(g4.w), bq[3] * bf_hi(g4.w));
                *(u32x4*)(yp + 16 * pr) = w;
            }
            ss += __shfl_xor(ss, 32);
            if (h == 0) ssb[row * 32 + g * 2 + dt] = ss;
        }
    }
    __syncthreads();
}

#define XB_TMO      128
#define XB_XCNT(j)  (256  + 64 * (j))
#define XB_XSUB(j)  (1280 + 64 * (j))
#define XB_XGEN(j)  (2304 + 64 * (j))
#define XB_TOP      3328
#define XB_TOPGEN   3392
#define XCD_BAR_WORDS 3456
#define XB_SPIN_CAP (1u << 18)

__device__ __forceinline__ unsigned xb_ld(unsigned* p)              { return __hip_atomic_load(p, __ATOMIC_RELAXED, __HIP_MEMORY_SCOPE_AGENT); }
__device__ __forceinline__ unsigned xb_add(unsigned* p, unsigned v) { return __hip_atomic_fetch_add(p, v, __ATOMIC_RELAXED, __HIP_MEMORY_SCOPE_AGENT); }
__device__ __forceinline__ unsigned xb_xcc_id() { return (unsigned)__builtin_amdgcn_s_getreg((3 << 11) | 20) & 0xFu; }
#define XB_SPIN(cond, bar) do { unsigned _sp = 0; while (cond) { __builtin_amdgcn_s_sleep(1); \
    if ((++_sp & 255u) == 0u) { if (xb_ld(&(bar)[XB_TMO])) break; if (_sp > XB_SPIN_CAP) { atomicAdd(&(bar)[XB_TMO], 1u); break; } } } } while (0)

struct XcdBarrier {
    unsigned* bar; unsigned x;
    volatile LAS unsigned* st;
};

__device__ __forceinline__ XcdBarrier xcd_barrier_post(unsigned* bar, volatile LAS unsigned* st) {
    XcdBarrier b; b.bar = bar; b.x = xb_xcc_id(); b.st = st;
    if (threadIdx.x == 0) (void)xb_add(&bar[XB_XCNT(b.x)], 1u);
    return b;
}
__device__ __forceinline__ void xcd_barrier_complete(unsigned* bar, unsigned x, unsigned& nloc, unsigned& nx) {
    const unsigned G = gridDim.x * gridDim.y * gridDim.z;
    unsigned sum, cnt, mine, sp = 0u;
    for (;;) {
        sum = 0u; cnt = 0u; mine = 0u;
#pragma unroll
        for (unsigned j = 0; j < 16; ++j) { const unsigned c = xb_ld(&bar[XB_XCNT(j)]); sum += c; cnt += (c > 0u) ? 1u : 0u; mine = (j == x) ? c : mine; }
        if (sum == G) break;
        __builtin_amdgcn_s_sleep(1);
        if ((++sp & 255u) == 0u) { if (xb_ld(&bar[XB_TMO])) break; if (sp > XB_SPIN_CAP) { atomicAdd(&bar[XB_TMO], 1u); break; } }
    }
    nloc = mine > 0u ? mine : 1u; nx = cnt > 0u ? cnt : 1u;
}

__device__ __forceinline__ void xcd_barrier(const XcdBarrier& b) {
    asm volatile("s_waitcnt vmcnt(0)" ::: "memory");
    __syncthreads();
    if (threadIdx.x == 0) {
        unsigned* bar = b.bar;
        __builtin_amdgcn_s_waitcnt(0);
        unsigned nloc = b.st[0], nx = b.st[1];
        if (nloc == 0u) { xcd_barrier_complete(bar, b.x, nloc, nx); b.st[0] = nloc; b.st[1] = nx; }
        const unsigned old = xb_add(&bar[XB_XSUB(b.x)], 1u);
        const unsigned gen = old / nloc;
        if (old + 1u == (gen + 1u) * nloc) {
            __builtin_amdgcn_fence(__ATOMIC_RELEASE, "agent");
            asm volatile("s_waitcnt vmcnt(0)" ::: "memory");
            const unsigned og = xb_add(&bar[XB_TOP], 1u);
            const unsigned tg = og / nx;
            if (og + 1u == (tg + 1u) * nx) xb_add(&bar[XB_TOPGEN], 1u);
            else XB_SPIN(xb_ld(&bar[XB_TOPGEN]) == tg, bar);
            __builtin_amdgcn_fence(__ATOMIC_ACQUIRE, "agent");
            xb_add(&bar[XB_XGEN(b.x)], 1u);
            asm volatile("s_waitcnt vmcnt(0)" ::: "memory");
        } else {
            XB_SPIN(xb_ld(&bar[XB_XGEN(b.x)]) == gen, bar);
            __builtin_amdgcn_fence(__ATOMIC_ACQUIRE, "agent");
            asm volatile("s_waitcnt vmcnt(0)" ::: "memory");
        }
    }
    __syncthreads();
}


struct OneUnit { int pm, pn; __device__ bool next(int i, pg8::Unit& u) const { if (i != 0) return false; u.pm = pm; u.pn = pn; return true; } };

template <class Sched>
__device__ __forceinline__ void run_in_proj(LAS unsigned char* lds, const Params& p, int l, const Sched& S, int M, int rows_off, int wave, int stage_off = -1) {
    unsigned char* ws = p.ws;
    const float* SSX = (const float*)(ws + WS_SSX);
    {
        const int ln = lane_fresh(), t = wave * 64 + ln, r = t >> 1, hf = t & 1;
        LAS float* rows = (LAS float*)(lds + rows_off); pg8::Unit u;
        for (int i = 0; i < 12 && S.next(i, u); ++i) {
            const f32x4* sp = (const f32x4*)(SSX + ((size_t)u.pm * 256 + r) * 32 + hf * 16);
            float sm = (sum4(sp[0]) + sum4(sp[1])) + (sum4(sp[2]) + sum4(sp[3]));
            sm += __shfl_xor(sm, 1);
            if (hf == 0) rows[i * 256 + r] = __builtin_amdgcn_rsqf(sm * (1.0f / 2048.0f) + EPS);
        }
        __syncthreads();
    }
    pg8::Gemm g{(const bf16_t*)(ws + WS_XB), (const bf16_t*)(ws + WS_WIN) + (size_t)l * DPROJ * DM, M, DPROJ, DM};
    EpiIn E{(bf16_t*)(ws + WS_P), (const LAS float*)(lds + rows_off), (float*)(ws + WS_SVG), p.out + OUT_KNP + (size_t)l * 524288, p.out + OUT_NVP + (size_t)l * 524288, p.out + OUT_NKS + (size_t)l * 1048576, p.out + OUT_NVS + (size_t)l * 1048576,
            stage_off >= 0 ? lds + stage_off : (LAS unsigned char*)nullptr};
    pg8::gemm_phase<EpiIn, Sched>(lds, g, S, E, wave);
}
template <class Sched>
__device__ __forceinline__ void run_out_proj(LAS unsigned char* lds, const Params& p, int l, const Sched& S, int M, int rows_off, int wave) {
    unsigned char* ws = p.ws;
    const float* SSA = (const float*)(ws + WS_SSA); const float* SSB = (const float*)(ws + WS_SSB);
    {
        const int ln = lane_fresh(), t = wave * 64 + ln, r = t >> 1, hf = t & 1;
        LAS float* rows = (LAS float*)(lds + rows_off); pg8::Unit u;
        for (int i = 0; i < 10 && S.next(i, u); ++i) {
            const size_t row = (size_t)u.pm * 256 + r;
            const f32x4* ap = (const f32x4*)(SSA + row * 16 + hf * 8); const f32x4* bp = (const f32x4*)(SSB + row * 32 + hf * 16);
            float sa = sum4(ap[0]) + sum4(ap[1]), sb = (sum4(bp[0]) + sum4(bp[1])) + (sum4(bp[2]) + sum4(bp[3]));
            sa += __shfl_xor(sa, 1); sb += __shfl_xor(sb, 1);
            const float a = sa * (1.0f / 1024.0f) + EPS, b = sb * (1.0f / 1024.0f) + EPS;
            if (hf == 0) { rows[i * 768 + r] = __builtin_sqrtf(a); rows[i * 768 + 256 + r] = __builtin_amdgcn_rsqf(a) * __builtin_sqrtf(b); rows[i * 768 + 512 + r] = __builtin_amdgcn_rsqf(b); }
        }
        __syncthreads();
    }
    pg8::Gemm g{(const bf16_t*)(ws + WS_Y), (const bf16_t*)(ws + WS_WOUT) + (size_t)l * DM * DM, M, DM, DM};
    EpiOut E{p.out, (bf16_t*)(ws + WS_XB), (float*)(ws + WS_SSX), (const LAS float*)(lds + rows_off), 0};
    pg8::gemm_phase<EpiOut, Sched>(lds, g, S, E, wave);
}

__device__ __forceinline__ void block_arrive(unsigned* cnt) {
    asm volatile("s_waitcnt vmcnt(0)" ::: "memory");
    __syncthreads();
    if (threadIdx.x == 0) { __builtin_amdgcn_fence(__ATOMIC_RELEASE, "agent"); asm volatile("s_waitcnt vmcnt(0)" ::: "memory"); (void)__hip_atomic_fetch_add(cnt, 1u, __ATOMIC_RELAXED, __HIP_MEMORY_SCOPE_AGENT); }
}
__device__ __forceinline__ void block_wait(unsigned* cnt, unsigned want) {
    if (threadIdx.x == 0) {
        unsigned spins = 0;
        while (__hip_atomic_load(cnt, __ATOMIC_RELAXED, __HIP_MEMORY_SCOPE_AGENT) < want) { __builtin_amdgcn_s_sleep(4); if (++spins > (1u << 24)) break; }
        __builtin_amdgcn_fence(__ATOMIC_ACQUIRE, "agent"); asm volatile("s_waitcnt vmcnt(0)" ::: "memory");
    }
    __syncthreads();
}

__device__ __forceinline__ void p2_phase(LAS unsigned char* lds, const Params& p, int l, int tid, int wave, int lane, int bid, int G) {
    lane = lane_fresh(); tid = wave * 64 + lane;
    unsigned char* ws = p.ws;
    const bf16_t* P = (const bf16_t*)(ws + WS_P); bf16_t* Y = (bf16_t*)(ws + WS_Y);
    const float* SVG = (const float*)(ws + WS_SVG); float* SSA = (float*)(ws + WS_SSA); float* SSB = (float*)(ws + WS_SSB);
    unsigned* CNT = (unsigned*)(ws + WS_CNT) + l * 512;
    LAS float* BIAS = (LAS float*)(lds + L_BIAS);
    for (int id = tid; id < 16 * 256; id += 512) {
        const int hh = id >> 8, idx = id & 255, rel = idx - 191, n = rel < 0 ? -rel : rel;
        int bk = n; if (n >= 8) { bk = 33 - __builtin_clz((unsigned)(n * n)); if (bk > 15) bk = 15; }
        bk += (rel > 0) ? 16 : 0;
        BIAS[id] = p.rel_bias[bk * 16 + hh] * LOG2E;
    }
    __syncthreads();
    if (bid < 128) attn_task(lds, p, P, Y, SSA, l, true, bid >> 2, 0, bid & 3, tid, wave, lane);
    else { const int u = bid - 128; gmlp_task(lds, p, P, Y, SVG, SSB, l, true, 0, u >> 3, u & 7, tid, wave, lane); }
    block_arrive(CNT);
    const int ngemm = (l < DEPTH - 1) ? 120 : 32;
    int start, count;
    if (bid < ngemm) { start = bid * 10; count = 10; }
    else { const int rest = 3072 - ngemm * 10, nb = 256 - ngemm, q = rest / nb, rem = rest - q * nb, j = bid - ngemm; start = ngemm * 10 + j * q + (j < rem ? j : rem); count = q + (j < rem ? 1 : 0); }
    const int end = start + count;
    const int ta0 = 2 * (start / 3) + (start % 3 < 2 ? start % 3 : 2), ta1 = 2 * (end / 3) + (end % 3 < 2 ? end % 3 : 2), ug0 = start / 3, ug1 = end / 3;
    const int tsplit = (bid < 32) ? (ta0 + 2 < ta1 ? ta0 + 2 : ta1) : ta1;
    attn_run(lds, p, P, Y, SSA, l, ta0, tsplit, wave);
    if (bid < 32) {
        block_wait(CNT, 256u);
        OneUnit S{128 + (bid >> 3), bid & 7};
        run_out_proj<OneUnit>(lds, p, l, S, MT, L_ROWS + 16384, wave);
        block_arrive(CNT + 64 * (1 + (bid >> 3)));
    }
    attn_run(lds, p, P, Y, SSA, l, tsplit, ta1, wave);
    for (int u = ug0; u < ug1; ++u)
        gmlp_task(lds, p, P, Y, SVG, SSB, l, false, (u >> 2) & 15, u >> 6, u & 3, tid, wave, lane, u == ug0 || (u >> 6) != ((u - 1) >> 6));
    if (bid >= 32 && bid < ngemm) {
        const int idx = bid - 32, tile = idx / 22;
        block_wait(CNT + 64 * (1 + tile), 8u);
        OneUnit S{128 + tile, idx - tile * 22};
        run_in_proj<OneUnit>(lds, p, l + 1, S, MT, L_ROWS + 16384, wave);
    }
}

__global__ void __launch_bounds__(512, 2) fwd_megakernel(Params p) {
    extern __shared__ __attribute__((aligned(16))) unsigned char lds_raw[];
    LAS unsigned char* lds = (LAS unsigned char*)lds_raw;
    cg::grid_group grid = cg::this_grid();
    const int wave = __builtin_amdgcn_readfirstlane(threadIdx.x >> 6), tid = 0, lane = 0, G = gridDim.x, bid = blockIdx.x;
    unsigned char* ws = p.ws;
    float* SSX = (float*)(ws + WS_SSX);

    {
        volatile LAS unsigned* st = (volatile LAS unsigned*)(lds + LDS_BYTES - 64);
        if (threadIdx.x < 2) st[threadIdx.x] = 0u;
        __syncthreads();
    }
    const XcdBarrier xbar = xcd_barrier_post((unsigned*)(ws + WS_CNT) + 4096, (volatile LAS unsigned*)(lds + LDS_BYTES - 64));
    prologue(lds, p, tid, wave, lane, bid, G);
    grid.sync();
#pragma unroll 1
    for (int l = 0; l < DEPTH; ++l) {
        {
            const int M = (l == 0) ? MT : NP;
            pg8::StaticOrder S; S.init(M, DPROJ, G, bid);
            run_in_proj<pg8::StaticOrder>(lds, p, l, S, M, L_ROWS, wave, L_ROWS + 12288);
        }
        xcd_barrier(xbar);
        p2_phase(lds, p, l, tid, wave, lane, bid, G);
        xcd_barrier(xbar);
        {
            pg8::StaticOrder S; S.init(NP, DM, G, bid);
            run_out_proj<pg8::StaticOrder>(lds, p, l, S, NP, L_ROWS, wave);
        }
        xcd_barrier(xbar);
    }
    {
        const int ll = lane_fresh();
        const int gw = bid * 8 + wave, NGW = G * 8;
        const f32x4* gf = (const f32x4*)p.norm_final + ll;
        const bf16_t* XBf = (const bf16_t*)(ws + WS_XB);
        f32x4 gv[8];
#pragma unroll
        for (int j = 0; j < 8; ++j) gv[j] = gf[64 * j];
        for (int row = gw; row < MT; row += 2 * NGW) {
            const int row2 = row + NGW; const bool two = row2 < MT; const int rb = two ? row2 : row;
            const u32x2* xa = (const u32x2*)(XBf + (size_t)row * DM) + ll; const u32x2* xb2 = (const u32x2*)(XBf + (size_t)rb * DM) + ll;
            u32x2 wa[8], wb[8];
#pragma unroll
            for (int j = 0; j < 8; ++j) wa[j] = xa[64 * j];
#pragma unroll
            for (int j = 0; j < 8; ++j) wb[j] = xb2[64 * j];
            const float pa = ll < 32 ? SSX[(size_t)row * 32 + ll] : 0.f, pb = ll < 32 ? SSX[(size_t)rb * 32 + ll] : 0.f;
            const float ra = __builtin_amdgcn_rsqf(wave_sum(pa) * (1.0f / 2048.0f) + EPS), rbs = __builtin_amdgcn_rsqf(wave_sum(pb) * (1.0f / 2048.0f) + EPS);
            f32x4* oa = (f32x4*)(p.out + (size_t)row * DM) + ll; f32x4* ob = (f32x4*)(p.out + (size_t)rb * DM) + ll;
#pragma unroll
            for (int j = 0; j < 8; ++j) { const u32x2 w = wa[j]; oa[64 * j] = (f32x4){bf_lo(w.x), bf_hi(w.x), bf_lo(w.y), bf_hi(w.y)} * ra * gv[j]; }
            if (two) {
#pragma unroll
                for (int j = 0; j < 8; ++j) { const u32x2 w = wb[j]; ob[64 * j] = (f32x4){bf_lo(w.x), bf_hi(w.x), bf_lo(w.y), bf_hi(w.y)} * rbs * gv[j]; }
            }
        }
    }
}

extern "C" void kernel_launch(void* const* d_in, const int* in_sizes, int n_in, void* d_out, int out_size, void* d_ws, size_t ws_size, hipStream_t stream) {
    static int grid = 0;
    if (grid == 0) {
        if (n_in != 16 || ws_size < WS_END) { fprintf(stderr, "kernel_launch: unexpected n_in %d / ws_size %zu\n", n_in, ws_size); grid = -1; return; }
        int dev = 0, cus = 0, per_cu = 0;
        hipGetDevice(&dev);
        hipDeviceGetAttribute(&cus, hipDeviceAttributeMultiprocessorCount, dev);
        hipFuncSetAttribute((const void*)fwd_megakernel, hipFuncAttributeMaxDynamicSharedMemorySize, LDS_BYTES);
        hipOccupancyMaxActiveBlocksPerMultiprocessor(&per_cu, (const void*)fwd_megakernel, 512, LDS_BYTES);
        if (per_cu < 1) per_cu = 1;
        (void)hipGetLastError();
        grid = cus * per_cu;
        if (grid != 256) { fprintf(stderr, "kernel_launch: this kernel's phase-2 schedule is built for a 256-workgroup grid, got %d\n", grid); grid = -1; return; }
    }
    if (grid < 0) return;
    Params p{};
    p.x_prompt = (const float*)d_in[0]; p.x_sample = (const float*)d_in[1]; p.cache_k = (const float*)d_in[2]; p.cache_v = (const float*)d_in[3];
    p.w_in = (const float*)d_in[4]; p.w_out = (const float*)d_in[5]; p.norm_in = (const float*)d_in[6]; p.rel_bias = (const float*)d_in[7]; p.sinks = (const float*)d_in[8];
    p.norm_attn = (const float*)d_in[9]; p.norm_gmlp = (const float*)d_in[10]; p.ln_v_g = (const float*)d_in[11]; p.ln_v_b = (const float*)d_in[12];
    p.w_spatial = (const float*)d_in[13]; p.b_spatial = (const float*)d_in[14]; p.norm_final = (const float*)d_in[15];
    p.out = (float*)d_out; p.ws = (unsigned char*)d_ws;
    (void)hipMemsetAsync((unsigned char*)d_ws + WS_CNT, 0, 65536, stream);
    void* args[] = {&p};
    hipError_t e = hipLaunchCooperativeKernel((const void*)fwd_megakernel, dim3(grid), dim3(512), args, LDS_BYTES, stream);
    if (e != hipSuccess) fprintf(stderr, "cooperative launch failed: %s (grid %d)\n", hipGetErrorString(e), grid);
}
```

```cpp
#include <hip/hip_runtime.h>
#include <hip/hip_cooperative_groups.h>
#include <cstdio>
#include <cstdint>
namespace cg = cooperative_groups;

#define LAS __attribute__((address_space(3)))
typedef unsigned short bf16_t;
typedef short bf16x8 __attribute__((ext_vector_type(8)));
typedef short s16x4 __attribute__((ext_vector_type(4)));
typedef float f32x4 __attribute__((ext_vector_type(4)));
typedef float f32x2 __attribute__((ext_vector_type(2)));
typedef float f32x16 __attribute__((ext_vector_type(16)));
typedef unsigned u32x4 __attribute__((ext_vector_type(4)));
typedef unsigned u32x2 __attribute__((ext_vector_type(2)));

constexpr int DM = 2048, NP = 16 * 2048, NS = 32 * 32, MT = NP + NS, DPROJ = 5632, DEPTH = 4;
constexpr int O_Q = 0, O_K = 1024, O_V = 1280, O_GA = 1536, O_U = 2560, O_VG = 3584, O_GB = 4608;
constexpr float EPS = 1e-6f, LOG2E = 1.4426950408889634f;
constexpr size_t OUT_KNP = (size_t)MT * DM, OUT_NVP = OUT_KNP + 2097152, OUT_NKS = OUT_NVP + 2097152, OUT_NVS = OUT_NKS + 4194304, OUT_VGS = OUT_NVS + 4194304;
constexpr size_t MiB = 1u << 20;
constexpr size_t WS_WIN = 0, WS_WOUT = 88 * MiB, WS_XB = 120 * MiB, WS_P = 252 * MiB, WS_Y = 616 * MiB, WS_SSX = 748 * MiB, WS_SVG = 753 * MiB, WS_SSA = 758 * MiB, WS_SSB = 761 * MiB, WS_CNT = 766 * MiB, WS_END = 767 * MiB;
static_assert((size_t)DEPTH * DPROJ * DM * 2 <= WS_WOUT && WS_WOUT + (size_t)DEPTH * DM * DM * 2 <= WS_XB && WS_XB + (size_t)MT * DM * 2 <= WS_P && WS_P + (size_t)MT * DPROJ * 2 <= WS_Y && WS_Y + (size_t)MT * DM * 2 <= WS_SSX, "ws map");
constexpr int LDS_BYTES = 163840, L_ROWS = 131072;

struct Params {
    const float *x_prompt, *x_sample, *cache_k, *cache_v, *w_in, *w_out, *norm_in, *rel_bias, *sinks, *norm_attn, *norm_gmlp, *ln_v_g, *ln_v_b, *w_spatial, *b_spatial, *norm_final;
    float* out; unsigned char* ws;
};

__device__ __forceinline__ unsigned f2bf(float f) { unsigned u = __builtin_bit_cast(unsigned, f); return (u + 0x7fffu + ((u >> 16) & 1u)) >> 16; }
typedef __bf16 bf16x2_t __attribute__((ext_vector_type(2)));
__device__ __forceinline__ unsigned pk2(float lo, float hi) { const f32x2 v = {lo, hi}; return __builtin_bit_cast(unsigned, __builtin_convertvector(v, bf16x2_t)); }
__device__ __forceinline__ float bf_lo(unsigned w) { return __builtin_bit_cast(float, w << 16); }
__device__ __forceinline__ float bf_hi(unsigned w) { return __builtin_bit_cast(float, w & 0xffff0000u); }
__device__ __forceinline__ float wave_sum(float v) {
#pragma unroll
    for (int o = 1; o < 64; o <<= 1) v += __shfl_xor(v, o);
    return v;
}
__device__ __forceinline__ int lane_fresh() { int l; asm volatile("v_mbcnt_lo_u32_b32 %0, -1, 0\n\tv_mbcnt_hi_u32_b32 %0, -1, %0" : "=v"(l)); return l; }
__device__ __forceinline__ void swap_halves(float& a, float& b) {
    const auto r = __builtin_amdgcn_permlane32_swap(__builtin_bit_cast(unsigned, a), __builtin_bit_cast(unsigned, b), false, false);
    unsigned x = r[0], y = r[1];
    asm volatile("" : "+v"(x), "+v"(y));
    a = __builtin_bit_cast(float, x); b = __builtin_bit_cast(float, y);
}
__device__ __forceinline__ float sum4(f32x4 v) { return (v[0] + v[1]) + (v[2] + v[3]); }
__device__ __forceinline__ float fq_sum(float v) { v += __shfl_xor(v, 16); v += __shfl_xor(v, 32); return v; }
__device__ __forceinline__ float silu_f(float v) { return v * __builtin_amdgcn_rcpf(1.0f + __builtin_amdgcn_exp2f(-v * LOG2E)); }
__device__ __forceinline__ f32x2 gelu_pk(f32x2 v) {
    f32x2 vc; vc.x = __builtin_amdgcn_fmed3f(v.x, -4.5f, 4.5f); vc.y = __builtin_amdgcn_fmed3f(v.y, -4.5f, 4.5f);
    const f32x2 t = vc * vc;
    f32x2 q = t * (-1.400032542e-12f) + 1.697268853e-10f;
    q = q * t + (-9.193600548e-09f); q = q * t + 2.958863661e-07f; q = q * t + (-6.365206445e-06f); q = q * t + 9.787092858e-05f;
    q = q * t + (-1.122676185e-03f); q = q * t + 9.833178483e-03f; q = q * t + (-6.633704901e-02f); q = q * t + 3.988837898e-01f;
    const f32x2 ph = vc * q + 0.5f;
    return v * ph;
}
__device__ __forceinline__ f32x4 gelu4(f32x4 v) { f32x2 a = gelu_pk((f32x2){v[0], v[1]}), b = gelu_pk((f32x2){v[2], v[3]}); return (f32x4){a.x, a.y, b.x, b.y}; }
__device__ __forceinline__ f32x4 silu4(f32x4 v) { return (f32x4){silu_f(v[0]), silu_f(v[1]), silu_f(v[2]), silu_f(v[3])}; }
__device__ __forceinline__ u32x4 pack8(f32x4 a, f32x4 b) { u32x4 w; w.x = pk2(a[0], a[1]); w.y = pk2(a[2], a[3]); w.z = pk2(b[0], b[1]); w.w = pk2(b[2], b[3]); return w; }

namespace pg8 {
constexpr int BM = 256, BK = 64, HALF = 128, HTB = HALF * BK * 2, STAGE_BYTES = 8 * HTB, NXCD = 8, WGM = 4;
__device__ __forceinline__ int lds_byte(int r, int c) { const int st = (r >> 4) * 2 + (c >> 5), rr = r & 15, cc = c & 31, ob = rr * 64 + cc * 2; return st * 1024 + (ob ^ (((ob >> 9) & 1) << 5)); }
__device__ __forceinline__ void stage_rc(int b, int& R, int& C) { const int st = b / 1024, sb = b % 1024, swz = sb ^ (((sb >> 9) & 1) << 5); R = (st >> 1) * 16 + swz / 64; C = (st & 1) * 32 + (swz % 64) / 2; }
__device__ __forceinline__ int perm32(int rho) { const int n = rho >> 4, i = rho & 15; return 8 * (i >> 2) + 4 * n + (i & 3); }
struct Unit { int pm, pn; };
struct Gemm { const bf16_t* A; const bf16_t* Bt; int M, N, K; };
struct StaticOrder {
    int nM, nN, nwg, G, c;
    __device__ void init(int M, int N, int G_, int c_) { nM = M / BM; nN = N / BM; nwg = nM * nN; G = G_; c = c_; }
    __device__ bool next(int i, Unit& u) const {
        const long L = (long)i * G + c; if (L >= nwg) return false;
        int wgid = (int)L; { const int q = nwg / NXCD, r = nwg % NXCD, xcd = wgid % NXCD, off = wgid / NXCD; wgid = (xcd < r ? xcd * (q + 1) : r * (q + 1) + (xcd - r) * q) + off; }
        const int nig = WGM * nN, gid = wgid / nig, fm = gid * WGM, gsz = (nM - fm) < WGM ? (nM - fm) : WGM;
        u.pm = fm + ((wgid % nig) % gsz); u.pn = (wgid % nig) / gsz; return true;
    }
};

template <class Epi, class Sched>
__device__ __forceinline__ void gemm_phase(LAS unsigned char* lds, const Gemm g, const Sched& S, const Epi& E, const int wid) {
    const int lane = lane_fresh(), tid = wid * 64 + lane, wr = wid >> 2, wc = wid & 3, fr = lane & 15, fq = lane >> 4;
    const int K = g.K, nt = K / BK;
    unsigned voffA[2], voffB[2];
#pragma unroll
    for (int i = 0; i < 2; ++i) { int R, C; stage_rc(tid * 16 + i * 8192, R, C); const int Rb = 2 * (R & ~31) + perm32(R & 31);
        voffA[i] = (unsigned)(R * K + C) * 2u; voffB[i] = (unsigned)(Rb * K + C) * 2u; }
    const size_t kstep = (size_t)(BK * 2);
    const size_t hstep = (size_t)HALF * K * 2;
    const size_t tstep = 2 * hstep;
    const size_t bstep = (size_t)32 * K * 2;
    const unsigned ldsw = (unsigned)wid * 1024u;
    const int aoff = lds_byte(wr * 64 + fr, fq * 8), boff = lds_byte(wc * 32 + fr, fq * 8);
#define PG8_SA(b, h) (((b) * 2 + (h)) * HTB)
#define PG8_SB(b, h) ((4 + (b) * 2 + (h)) * HTB)
#define PG8_STAGE(bufoff, gbase, voff) do { _Pragma("unroll") for (int _i = 0; _i < 2; ++_i) \
        __builtin_amdgcn_global_load_lds((const unsigned*)((const char*)(gbase) + (voff)[_i]), (LAS unsigned*)(lds + (bufoff) + ldsw + _i * 8192), 16, 0, 0); } while (0)
#define PG8_LDA(dst, b, h) do { _Pragma("unroll") for (int m = 0; m < 4; ++m) _Pragma("unroll") for (int k = 0; k < 2; ++k) dst[m][k] = *(const LAS bf16x8*)(lds + PG8_SA(b, h) + aoff + m * 2048 + k * 1024); } while (0)
#define PG8_LDB(dst, b, h) do { _Pragma("unroll") for (int n = 0; n < 2; ++n) _Pragma("unroll") for (int k = 0; k < 2; ++k) dst[n][k] = *(const LAS bf16x8*)(lds + PG8_SB(b, h) + boff + n * 2048 + k * 1024); } while (0)
#define PG8_MMA(ai, bj, At, Bt) do { __builtin_amdgcn_s_setprio(1); _Pragma("unroll") for (int m = 0; m < 4; ++m) _Pragma("unroll") for (int n = 0; n < 2; ++n) _Pragma("unroll") for (int k = 0; k < 2; ++k) \
        acc[ai][bj][m][n] = __builtin_amdgcn_mfma_f32_16x16x32_bf16(Bt[n][k], At[m][k], acc[ai][bj][m][n], 0, 0, 0); __builtin_amdgcn_s_setprio(0); } while (0)
#define PG8_WAIT_V(n) asm volatile("s_waitcnt vmcnt(" #n ")" ::: "memory")
#define PG8_WAIT_L(n) asm volatile("s_waitcnt lgkmcnt(" #n ")" ::: "memory")
#define PG8_BAR __builtin_amdgcn_s_barrier()
#define PG8_SCHED __builtin_amdgcn_sched_barrier(0)
    Unit cur, nxt; int ui = 0;
    if (!S.next(0, cur)) return;
    f32x4 acc[2][2][4][2];
    if constexpr (Epi::INIT) E.init(acc, cur, 0, wr, wc, fr, fq);
    else {
#pragma unroll
    for (int a = 0; a < 2; ++a)
#pragma unroll
        for (int b = 0; b < 2; ++b)
#pragma unroll
            for (int m = 0; m < 4; ++m)
#pragma unroll
                for (int n = 0; n < 2; ++n) acc[a][b][m][n] = (f32x4){0.f, 0.f, 0.f, 0.f};
    }
    bf16x8 At[4][2], B0[2][2], B1[2][2];
    const char* cA = (const char*)g.A + (size_t)cur.pm * tstep; const char* cB = (const char*)g.Bt + (size_t)cur.pn * tstep;
    PG8_STAGE(PG8_SB(0, 0), cB, voffB); PG8_STAGE(PG8_SB(0, 1), cB + bstep, voffB); PG8_STAGE(PG8_SA(0, 0), cA, voffA); PG8_STAGE(PG8_SA(0, 1), cA + hstep, voffA);
    if (wr == 1) PG8_BAR;
    PG8_WAIT_V(2); PG8_BAR;
    PG8_STAGE(PG8_SB(1, 0), cB + kstep, voffB); PG8_STAGE(PG8_SA(1, 0), cA + kstep, voffA); PG8_STAGE(PG8_SB(1, 1), cB + bstep + kstep, voffB);
    PG8_WAIT_V(6); PG8_BAR;
    for (;;) {
        const bool has_next = S.next(ui + 1, nxt);
        const char* nA = has_next ? (const char*)g.A + (size_t)nxt.pm * tstep : cA; const char* nB = has_next ? (const char*)g.Bt + (size_t)nxt.pn * tstep : cB;
        for (int t = 0; t < nt; t += 2) {
            const bool last = (t == nt - 2);
            const char* a1 = cA + (size_t)(t + 1) * kstep;
            const char* a2 = last ? nA : cA + (size_t)(t + 2) * kstep; const char* b2 = last ? nB : cB + (size_t)(t + 2) * kstep;
            const char* a3 = a2 + kstep; const char* b3 = b2 + kstep;
            if constexpr (Epi::MID) { if (t == nt / 2) E.mid(acc, cur, ui, wr, wc, fr, fq); }
            PG8_LDB(B0, 0, 0); PG8_LDB(B1, 0, 1); PG8_SCHED; PG8_LDA(At, 0, 0); PG8_STAGE(PG8_SA(1, 1), a1 + hstep, voffA);
            PG8_WAIT_V(8); PG8_WAIT_L(0); PG8_BAR; PG8_MMA(0, 0, At, B0); PG8_MMA(0, 1, At, B1); PG8_BAR; PG8_SCHED;
            PG8_LDA(At, 0, 1); PG8_STAGE(PG8_SB(0, 0), b2, voffB); PG8_STAGE(PG8_SB(0, 1), b2 + bstep, voffB); PG8_STAGE(PG8_SA(0, 0), a2, voffA);
            PG8_WAIT_V(8); PG8_WAIT_L(0); PG8_BAR; PG8_MMA(1, 0, At, B0); PG8_MMA(1, 1, At, B1); PG8_BAR; PG8_SCHED;
            PG8_LDB(B0, 1, 0); PG8_LDB(B1, 1, 1); PG8_SCHED; PG8_LDA(At, 1, 0); PG8_STAGE(PG8_SA(0, 1), a2 + hstep, voffA);
            PG8_WAIT_V(8); PG8_WAIT_L(0); PG8_BAR; PG8_MMA(0, 0, At, B0); PG8_MMA(0, 1, At, B1); PG8_BAR; PG8_SCHED;
            PG8_LDA(At, 1, 1); PG8_STAGE(PG8_SB(1, 0), b3, voffB); PG8_STAGE(PG8_SB(1, 1), b3 + bstep, voffB); PG8_STAGE(PG8_SA(1, 0), a3, voffA);
            PG8_WAIT_V(8); PG8_WAIT_L(0); PG8_BAR; PG8_MMA(1, 0, At, B0); PG8_MMA(1, 1, At, B1); PG8_BAR; PG8_SCHED;
        }
        if (wr == 0) PG8_BAR;
        E(acc, cur, ui, wr, wc, fr, fq);
        if (!has_next) break;
        if constexpr (Epi::INIT) E.init(acc, nxt, ui + 1, wr, wc, fr, fq);
        else {
#pragma unroll
        for (int a = 0; a < 2; ++a)
#pragma unroll
            for (int b = 0; b < 2; ++b)
#pragma unroll
                for (int m = 0; m < 4; ++m)
#pragma unroll
                    for (int n = 0; n < 2; ++n) acc[a][b][m][n] = (f32x4){0.f, 0.f, 0.f, 0.f};
        }
        cur = nxt; cA = nA; cB = nB; ++ui;
        if (wr == 1) PG8_BAR;
    }
    PG8_WAIT_V(0);
    PG8_BAR;
#undef PG8_SA
#undef PG8_SB
#undef PG8_STAGE
#undef PG8_LDA
#undef PG8_LDB
#undef PG8_MMA
#undef PG8_WAIT_V
#undef PG8_WAIT_L
#undef PG8_BAR
#undef PG8_SCHED
}
}

struct EpiIn {
    static constexpr bool MID = false, INIT = false;
    bf16_t* P; const LAS float* rows; float* svg; float* knp; float* nvp; float* nks; float* nvs; LAS unsigned char* stg;
    template <int KIND>
    __device__ __forceinline__ void body(const f32x4 (&acc)[2][2][4][2], const pg8::Unit& u, int ui, int wr, int wc, int fr, int fq) const {
        const int row0 = u.pm * 256 + wr * 64 + fr;
        const int col0 = u.pn * 256 + wc * 64 + 8 * fq;
        const LAS float* rsl = rows + ui * 256 + wr * 64 + fr;
        const int sl = fq * 16 + fr, srow = sl >> 3, spc = sl & 7;
        LAS unsigned char* sw = stg ? stg + (wr * 4 + wc) * 2304 : nullptr;
#pragma unroll
        for (int ai = 0; ai < 2; ++ai)
#pragma unroll
            for (int m = 0; m < 4; ++m) {
                const int row = row0 + ai * 128 + m * 16;
                const float rs = rsl[ai * 128 + m * 16];
                bf16_t* rowp = P + (size_t)row * DPROJ + col0;
                float* dst = nullptr;
                if (KIND == 4) {
                    float* bp = (u.pn == 5) ? nvp : knp; float* bs = (u.pn == 5) ? nvs : nks;
                    if (u.pm < 128) { if ((u.pm & 7) == 7 && ai == 1) dst = bp + (size_t)((u.pm >> 3) * 128 + wr * 64 + m * 16 + fr) * 256 + wc * 64 + 8 * fq; }
                    else { const int sr = row - NP; dst = bs + (size_t)((sr >> 5) * 128 + 96 + (sr & 31)) * 256 + wc * 64 + 8 * fq; }
                }
                float s1 = 0.f, s2 = 0.f;
#pragma unroll
                for (int bj = 0; bj < 2; ++bj) {
                    f32x4 v0 = acc[ai][bj][m][0] * rs, v1 = acc[ai][bj][m][1] * rs;
                    if (KIND == 1) { v0 = silu4(v0); v1 = silu4(v1); }
                    if (KIND == 2 || KIND == 3) { v0 = gelu4(v0); v1 = gelu4(v1); }
                    if (KIND == 3) { s1 += (v0[0] + v0[1]) + (v0[2] + v0[3]) + (v1[0] + v1[1]) + (v1[2] + v1[3]);
                        s2 += (v0[0] * v0[0] + v0[1] * v0[1]) + (v0[2] * v0[2] + v0[3] * v0[3]) + (v1[0] * v1[0] + v1[1] * v1[1]) + (v1[2] * v1[2] + v1[3] * v1[3]); }
                    if (sw) *(LAS u32x4*)(sw + fr * 144 + bj * 64 + fq * 16) = pack8(v0, v1);
                    else *(u32x4*)(rowp + bj * 32) = pack8(v0, v1);
                    if (KIND == 4) { if (dst) { *(f32x4*)(dst + bj * 32) = v0; *(f32x4*)(dst + bj * 32 + 4) = v1; } }
                }
                if (sw) {
                    bf16_t* gb = P + (size_t)(u.pm * 256 + ai * 128 + wr * 64 + m * 16 + srow) * DPROJ + u.pn * 256 + wc * 64 + spc * 8;
                    const u32x4 w0 = *(const LAS u32x4*)(sw + srow * 144 + spc * 16), w1 = *(const LAS u32x4*)(sw + (srow + 8) * 144 + spc * 16);
                    *(u32x4*)gb = w0; *(u32x4*)(gb + (size_t)8 * DPROJ) = w1;
                }
                if (KIND == 3) {
                    s1 = fq_sum(s1); s2 = fq_sum(s2);
                    if (fq == 0) *(f32x2*)(svg + ((size_t)row * 16 + (u.pn - 14) * 4 + wc) * 2) = (f32x2){s1, s2};
                }
            }
    }
    __device__ __forceinline__ void operator()(const f32x4 (&acc)[2][2][4][2], const pg8::Unit& u, int ui, int wr, int wc, int fr, int fq) const {
        const int pn = u.pn;
        if (pn < 4) body<0>(acc, u, ui, wr, wc, fr, fq);
        else if (pn < 6) body<4>(acc, u, ui, wr, wc, fr, fq);
        else if (pn < 10 || pn >= 18) body<1>(acc, u, ui, wr, wc, fr, fq);
        else if (pn < 14) body<2>(acc, u, ui, wr, wc, fr, fq);
        else body<3>(acc, u, ui, wr, wc, fr, fq);
    }
};

struct EpiOut {
    static constexpr bool MID = true, INIT = true;
    float* out; bf16_t* xb; float* ssx; const LAS float* rows; int last; LAS unsigned char* stg;
    __device__ __forceinline__ void init(f32x4 (&acc)[2][2][4][2], const pg8::Unit& u, int ui, int wr, int wc, int fr, int fq) const {
        int row0 = u.pm * 256 + wr * 64 + fr;
        asm volatile("" : "+v"(row0));
        const int col0 = u.pn * 256 + wc * 64 + 8 * fq;
        const LAS float* rl = rows + ui * 768 + ((row0 - u.pm * 256));
#pragma unroll
        for (int ai = 0; ai < 2; ++ai)
#pragma unroll
            for (int m = 0; m < 4; ++m) {
                const int row = row0 + ai * 128 + m * 16;
                const bf16_t* base = xb + (size_t)row * DM + col0;
#pragma unroll
                for (int bj = 0; bj < 2; ++bj) { const u32x4 w = *(const u32x4*)(base + bj * 32);
                    acc[ai][bj][m][0] = (f32x4){bf_lo(w.x), bf_hi(w.x), bf_lo(w.y), bf_hi(w.y)}; acc[ai][bj][m][1] = (f32x4){bf_lo(w.z), bf_hi(w.z), bf_lo(w.w), bf_hi(w.w)}; }
            }
#pragma unroll
        for (int ai = 0; ai < 2; ++ai)
#pragma unroll
            for (int m = 0; m < 4; ++m) {
                const float ia = rl[ai * 128 + m * 16];
#pragma unroll
                for (int bj = 0; bj < 2; ++bj)
#pragma unroll
                    for (int n = 0; n < 2; ++n) acc[ai][bj][m][n] = acc[ai][bj][m][n] * ia;
            }
    }
    __device__ __forceinline__ void mid(f32x4 (&acc)[2][2][4][2], const pg8::Unit& u, int ui, int wr, int wc, int fr, int fq) const {
        int rt = wr * 64 + fr;
        asm volatile("" : "+v"(rt));
        const LAS float* rl = rows + ui * 768 + 256 + rt;
#pragma unroll
        for (int ai = 0; ai < 2; ++ai)
#pragma unroll
            for (int m = 0; m < 4; ++m) {
                const float ratio = rl[ai * 128 + m * 16];
#pragma unroll
                for (int bj = 0; bj < 2; ++bj)
#pragma unroll
                    for (int n = 0; n < 2; ++n) acc[ai][bj][m][n] = acc[ai][bj][m][n] * ratio;
            }
    }
    __device__ __forceinline__ void operator()(const f32x4 (&acc)[2][2][4][2], const pg8::Unit& u, int ui, int wr, int wc, int fr, int fq) const {
        const int row0 = u.pm * 256 + wr * 64 + fr;
        const int col0 = u.pn * 256 + wc * 64 + 8 * fq;
        const LAS float* rl = rows + ui * 768 + 512 + wr * 64 + fr;
        const int sl = fq * 16 + fr, srow = sl >> 3, spc = sl & 7;
        LAS unsigned char* sw = (stg && !last) ? stg + (wr * 4 + wc) * 2304 : nullptr;
#pragma unroll
        for (int ai = 0; ai < 2; ++ai)
#pragma unroll
            for (int m = 0; m < 4; ++m) {
                const int row = row0 + ai * 128 + m * 16;
                const float rb = rl[ai * 128 + m * 16];
                float* o = out + (size_t)row * DM + col0; bf16_t* xo = xb + (size_t)row * DM + col0;
                float ss = 0.f;
#pragma unroll
                for (int bj = 0; bj < 2; ++bj) {
                    const f32x4 v0 = acc[ai][bj][m][0] * rb, v1 = acc[ai][bj][m][1] * rb;
                    if (last) { *(f32x4*)(o + bj * 32) = v0; *(f32x4*)(o + bj * 32 + 4) = v1; }
                    else if (sw) *(LAS u32x4*)(sw + fr * 144 + bj * 64 + fq * 16) = pack8(v0, v1);
                    else *(u32x4*)(xo + bj * 32) = pack8(v0, v1);
                    ss += (v0[0] * v0[0] + v0[1] * v0[1]) + (v0[2] * v0[2] + v0[3] * v0[3]) + (v1[0] * v1[0] + v1[1] * v1[1]) + (v1[2] * v1[2] + v1[3] * v1[3]);
                }
                if (sw) {
                    bf16_t* gb = xb + (size_t)(u.pm * 256 + ai * 128 + wr * 64 + m * 16 + srow) * DM + u.pn * 256 + wc * 64 + spc * 8;
                    const u32x4 w0 = *(const LAS u32x4*)(sw + srow * 144 + spc * 16), w1 = *(const LAS u32x4*)(sw + (srow + 8) * 144 + spc * 16);
                    *(u32x4*)gb = w0; *(u32x4*)(gb + (size_t)8 * DM) = w1;
                }
                ss = fq_sum(ss);
                if (fq == 0) ssx[(size_t)row * 32 + u.pn * 4 + wc] = ss;
                asm volatile("" ::: "memory");
            }
    }
};

struct TItem { const float* W; const float* gk; bf16_t* WT; int N, k0, n0; };
__device__ __forceinline__ TItem p0_item(const Params& p, bf16_t* WIN, bf16_t* WOUT, int it) {
    constexpr int I_IN = (DM / 64) * (DPROJ / 32), I_OUT = (DM / 64) * (DM / 32), I_L = I_IN + I_OUT;
    const int l = it / I_L; int r = it - l * I_L; TItem t;
    if (r < I_IN) { const int nblk = DPROJ / 32, kb = r / nblk; t.k0 = 64 * kb; t.n0 = 32 * (r - kb * nblk); t.N = DPROJ; t.W = p.w_in + (size_t)l * DM * DPROJ; t.gk = p.norm_in + l * DM + t.k0; t.WT = WIN + (size_t)l * DPROJ * DM; }
    else { r -= I_IN; const int nblk = DM / 32, kb = r / nblk; t.k0 = 64 * kb; t.n0 = 32 * (r - kb * nblk); t.N = DM; t.W = p.w_out + (size_t)l * DM * DM;
        t.gk = (t.k0 < 1024) ? p.norm_attn + l * 1024 + t.k0 : p.norm_gmlp + l * 1024 + (t.k0 - 1024); t.WT = WOUT + (size_t)l * DM * DM; }
    return t;
}
__device__ __forceinline__ void p0_load(const TItem& t, f32x4 (&v)[8], int lane) {
#pragma unroll
    for (int i = 0; i < 8; ++i) { const int kk = 8 * i + (lane >> 3); v[i] = *(const f32x4*)(t.W + (size_t)(t.k0 + kk) * t.N + t.n0 + 4 * (lane & 7)) * t.gk[kk]; }
}
__device__ __forceinline__ void p0_emit(const TItem& t, const f32x4 (&v)[8], LAS float* scr, int lane) {
#pragma unroll
    for (int i = 0; i < 8; ++i) { LAS float* d = scr + (8 * i + (lane >> 3)) * 33 + 4 * (lane & 7); d[0] = v[i][0]; d[1] = v[i][1]; d[2] = v[i][2]; d[3] = v[i][3]; }
    asm volatile("s_waitcnt lgkmcnt(0)" ::: "memory");
    const int c = lane & 7;
#pragma unroll
    for (int j = 0; j < 4; ++j) { const int n = (lane >> 3) + 8 * j; const LAS float* sp = scr + (8 * c) * 33 + n;
        u32x4 o; o.x = pk2(sp[0 * 33], sp[1 * 33]); o.y = pk2(sp[2 * 33], sp[3 * 33]); o.z = pk2(sp[4 * 33], sp[5 * 33]); o.w = pk2(sp[6 * 33], sp[7 * 33]);
        *(u32x4*)(t.WT + (size_t)(t.n0 + n) * DM + t.k0 + 8 * c) = o; }
    asm volatile("s_waitcnt lgkmcnt(0)" ::: "memory");
}

__device__ __forceinline__ void prologue(LAS unsigned char* lds, const Params& p, int tid, int wave, int lane, int bid, int G) {
    lane = lane_fresh(); tid = wave * 64 + lane;
    unsigned char* ws = p.ws;
    bf16_t* WIN = (bf16_t*)(ws + WS_WIN); bf16_t* WOUT = (bf16_t*)(ws + WS_WOUT); bf16_t* XB = (bf16_t*)(ws + WS_XB);
    float* SSX = (float*)(ws + WS_SSX);
    LAS float* scr = (LAS float*)(lds + wave * 17408);
    const int gw = bid * 8 + wave, NGW = G * 8;
    constexpr int NIT = DEPTH * ((DM / 64) * (DPROJ / 32) + (DM / 64) * (DM / 32));
    for (int it = gw; it < NIT; it += 2 * NGW) {
        const bool two = it + NGW < NIT;
        const TItem ta = p0_item(p, WIN, WOUT, it), tb = p0_item(p, WIN, WOUT, two ? it + NGW : it);
        f32x4 va[8], vb[8];
        p0_load(ta, va, lane); if (two) p0_load(tb, vb, lane);
        p0_emit(ta, va, scr, lane); if (two) p0_emit(tb, vb, scr + 64 * 33, lane);
    }
    for (int row = gw; row < MT; row += 2 * NGW) {
        const int row2 = row + NGW; const bool two = row2 < MT; const int rb = two ? row2 : row;
        const f32x4* xa = (const f32x4*)(row < NP ? p.x_prompt + (size_t)row * DM : p.x_sample + (size_t)(row - NP) * DM) + lane;
        const f32x4* xb2 = (const f32x4*)(rb < NP ? p.x_prompt + (size_t)rb * DM : p.x_sample + (size_t)(rb - NP) * DM) + lane;
        f32x4 va[8], vb[8];
#pragma unroll
        for (int j = 0; j < 8; ++j) va[j] = xa[64 * j];
#pragma unroll
        for (int j = 0; j < 8; ++j) vb[j] = xb2[64 * j];
        u32x2* oa = (u32x2*)(XB + (size_t)row * DM) + lane; u32x2* ob = (u32x2*)(XB + (size_t)rb * DM) + lane;
        float sa = 0.f, sb = 0.f;
#pragma unroll
        for (int j = 0; j < 8; ++j) { const f32x4 v = va[j]; sa += (v[0] * v[0] + v[1] * v[1]) + (v[2] * v[2] + v[3] * v[3]); u32x2 w; w.x = pk2(v[0], v[1]); w.y = pk2(v[2], v[3]); oa[64 * j] = w; }
        if (two) {
#pragma unroll
            for (int j = 0; j < 8; ++j) { const f32x4 v = vb[j]; sb += (v[0] * v[0] + v[1] * v[1]) + (v[2] * v[2] + v[3] * v[3]); u32x2 w; w.x = pk2(v[0], v[1]); w.y = pk2(v[2], v[3]); ob[64 * j] = w; }
        }
        sa = wave_sum(sa); sb = wave_sum(sb);
        if (lane < 32) { SSX[(size_t)row * 32 + lane] = (lane == 0) ? sa : 0.f; if (two) SSX[(size_t)row2 * 32 + lane] = (lane == 0) ? sb : 0.f; }
    }
    for (int seg = bid; seg < 256; seg += G) {
        const int kv = seg >> 7, lb = seg & 127;
        const f32x4* src = (const f32x4*)((kv ? p.cache_v : p.cache_k) + ((size_t)lb * 128 + 32) * 256);
        f32x4* dst = (f32x4*)(p.out + (kv ? OUT_NVS : OUT_NKS) + (size_t)lb * 128 * 256);
        for (int i = tid; i < 96 * 64; i += 512) dst[i] = src[i];
    }
}

constexpr int L_KS = 0, L_VT = 27648, L_WS = 73728, L_MUR = 108544, L_BIAS = 131072;
#define MFMA32(a, b, c) __builtin_amdgcn_mfma_f32_32x32x16_bf16((a), (b), (c), 0, 0, 0)
__device__ __forceinline__ bf16x8 pack_step(const f32x16& x, int s) {
    u32x4 w; w.x = pk2(x[8 * s], x[8 * s + 1]); w.y = pk2(x[8 * s + 2], x[8 * s + 3]); w.z = pk2(x[8 * s + 4], x[8 * s + 5]); w.w = pk2(x[8 * s + 6], x[8 * s + 7]);
    return __builtin_bit_cast(bf16x8, w);
}

__device__ __forceinline__ void attn_task(LAS unsigned char* lds, const Params& p, const bf16_t* P, bf16_t* Y, float* ssa, int l, bool sample, int b, int c, int kvh, int tid, int wave, int lane) {
    lane = lane_fresh(); tid = wave * 64 + lane;
    LAS bf16_t* KS = (LAS bf16_t*)(lds + L_KS);
    LAS bf16_t* VT = (LAS bf16_t*)(lds + L_VT);
    const LAS float* BIAS = (const LAS float*)(lds + L_BIAS);
    const int nk = sample ? 160 : 192;
    const int jmin = sample ? 0 : (c >= 2 ? 0 : (2 - c) * 64);
    for (int id = tid; id < nk * 8; id += 512) {
        const int j = id >> 3, ch = id & 7;
        if (j >= jmin) {
            u32x4 w;
            if (sample && j < 128) { const float* src = p.cache_k + ((((size_t)l * 32 + b) * 128 + j) * 4 + kvh) * 64 + ch * 8; w = pack8(*(const f32x4*)src, *(const f32x4*)(src + 4)); }
            else { const size_t row = sample ? (size_t)NP + b * 32 + (j - 128) : (size_t)b * 2048 + (c - 2) * 64 + j; w = *(const u32x4*)(P + row * DPROJ + O_K + kvh * 64 + ch * 8); }
            *(LAS u32x4*)(KS + j * 72 + ch * 8) = w;
        }
    }
    for (int id = tid; id < nk * 8; id += 512) {
        const int ch = id / nk, j = id - ch * nk;
        if (j >= jmin) {
            u32x4 w;
            if (sample && j < 128) { const float* src = p.cache_v + ((((size_t)l * 32 + b) * 128 + j) * 4 + kvh) * 64 + ch * 8; w = pack8(*(const f32x4*)src, *(const f32x4*)(src + 4)); }
            else { const size_t row = sample ? (size_t)NP + b * 32 + (j - 128) : (size_t)b * 2048 + (c - 2) * 64 + j; w = *(const u32x4*)(P + row * DPROJ + O_V + kvh * 64 + ch * 8); }
#pragma unroll
            for (int e = 0; e < 4; ++e) { VT[(ch * 8 + 2 * e) * 200 + j] = (bf16_t)(w[e] & 0xffffu); VT[(ch * 8 + 2 * e + 1) * 200 + j] = (bf16_t)(w[e] >> 16); }
        }
    }
    __syncthreads();
    const int r = lane & 31, h = lane >> 5;
    const bool active = sample ? (wave < 4) : true;
    if (active) {
        const int g = sample ? wave : (wave >> 1), qh = sample ? 0 : (wave & 1);
        const int head = kvh * 4 + g, i = 32 * qh + r;
        const size_t qrow = sample ? (size_t)NP + b * 32 + i : (size_t)b * 2048 + c * 64 + i;
        bf16x8 qf[4];
#pragma unroll
        for (int s = 0; s < 4; ++s) qf[s] = *(const bf16x8*)(P + qrow * DPROJ + O_Q + head * 64 + 16 * s + 8 * h);
        const bf16_t* gp = P + qrow * DPROJ + O_GA + head * 64 + 8 * h;
        u32x4 gwv[4];
#pragma unroll
        for (int e = 0; e < 4; ++e) gwv[e] = *(const u32x4*)(gp + 16 * e);
        const int T0 = jmin >> 5, NT = nk >> 5;
        f32x16 st[6];
#pragma unroll
        for (int T = 0; T < 6; ++T) {
            f32x16 acc;
            if (T >= T0 && T < NT) {
#pragma unroll
                for (int e = 0; e < 16; ++e) acc[e] = 0.f;
#pragma unroll
                for (int s = 0; s < 4; ++s) { const bf16x8 a = *(const LAS bf16x8*)(KS + (32 * T + r) * 72 + 16 * s + 8 * h); acc = MFMA32(a, qf[s], acc); }
            } else {
#pragma unroll
                for (int e = 0; e < 16; ++e) acc[e] = -1e30f;
            }
            st[T] = acc;
        }
        const float sc = 0.125f * LOG2E;
        const LAS float* bl = BIAS + head * 256 + 63 - i + 4 * h;
        float mx = -3e38f;
#pragma unroll
        for (int T = 0; T < 6; ++T)
            if (T >= T0 && T < NT) {
#pragma unroll
                for (int e = 0; e < 16; ++e) { const float v = st[T][e] * sc + bl[32 * T + (e & 3) + 8 * (e >> 2)]; st[T][e] = v; mx = fmaxf(mx, v); }
                }
        mx = fmaxf(mx, __shfl_xor(mx, 32));
        const float sink2 = p.sinks[l * 16 + head] * LOG2E;
        mx = fmaxf(mx, sink2);
        float sum = 0.f;
#pragma unroll
        for (int T = 0; T < 6; ++T)
#pragma unroll
            for (int e = 0; e < 16; ++e) { const float pv = __builtin_amdgcn_exp2f(st[T][e] - mx); st[T][e] = pv; sum += pv; }
        sum += __shfl_xor(sum, 32);
        sum += __builtin_amdgcn_exp2f(sink2 - mx);
        const float inv = 1.0f / sum;
        f32x16 o[2];
#pragma unroll
        for (int e = 0; e < 16; ++e) { o[0][e] = 0.f; o[1][e] = 0.f; }
#pragma unroll
        for (int T = 0; T < 6; ++T)
            if (T >= T0 && T < NT) {
#pragma unroll
                for (int s = 0; s < 2; ++s) {
                    const bf16x8 xs = pack_step(st[T], s);
#pragma unroll
                    for (int dt = 0; dt < 2; ++dt) {
                        const LAS bf16_t* vp = VT + (32 * dt + r) * 200 + 32 * T + 16 * s + 4 * h;
                        const s16x4 lo = *(const LAS s16x4*)vp, hi = *(const LAS s16x4*)(vp + 8);
                        const bf16x8 pa = __builtin_shufflevector(lo, hi, 0, 1, 2, 3, 4, 5, 6, 7);
                        o[dt] = MFMA32(pa, xs, o[dt]);
                    }
                }
                }
        float ss = 0.f;
        bf16_t* yp = Y + qrow * DM + head * 64 + 8 * h;
#pragma unroll
        for (int dt = 0; dt < 2; ++dt)
#pragma unroll
            for (int pr = 0; pr < 2; ++pr) {
                float a[4], bq[4];
#pragma unroll
                for (int k = 0; k < 4; ++k) { a[k] = o[dt][8 * pr + k] * inv; bq[k] = o[dt][8 * pr + 4 + k] * inv; }
                ss += ((a[0] * a[0] + a[1] * a[1]) + (a[2] * a[2] + a[3] * a[3])) + ((bq[0] * bq[0] + bq[1] * bq[1]) + (bq[2] * bq[2] + bq[3] * bq[3]));
#pragma unroll
                for (int k = 0; k < 4; ++k) swap_halves(a[k], bq[k]);
                const u32x4 gw = gwv[2 * dt + pr];
                u32x4 w; w.x = pk2(a[0] * bf_lo(gw.x), a[1] * bf_hi(gw.x)); w.y = pk2(a[2] * bf_lo(gw.y), a[3] * bf_hi(gw.y));
                w.z = pk2(bq[0] * bf_lo(gw.z), bq[1] * bf_hi(gw.z)); w.w = pk2(bq[2] * bf_lo(gw.w), bq[3] * bf_hi(gw.w));
                *(u32x4*)(yp + 32 * dt + 16 * pr) = w;
            }
        ss += __shfl_xor(ss, 32);
        if (h == 0) ssa[qrow * 16 + head] = ss;
    }
    __syncthreads();
}

__device__ __forceinline__ void attn_run(LAS unsigned char* lds, const Params& p, const bf16_t* P, bf16_t* Y, float* ssa, int l, int t0, int t1, int wave) {
    if (t0 >= t1) return;
    const int lane = lane_fresh(), tid = wave * 64 + lane;
    LAS bf16_t* KS = (LAS bf16_t*)(lds + L_KS);
    LAS bf16_t* VT = (LAS bf16_t*)(lds + L_VT);
    const LAS float* BIAS = (const LAS float*)(lds + L_BIAS);
    const int r = lane & 31, h = lane >> 5;
    const int jk = tid >> 3, chk = tid & 7;
    const int jv = tid & 63, chv = tid >> 6;
    u32x4 pk = (u32x4){0u, 0u, 0u, 0u}, pv = pk;
    bf16x8 qn[4];
#pragma unroll
    for (int s = 0; s < 4; ++s) qn[s] = (bf16x8){0, 0, 0, 0, 0, 0, 0, 0};
    int prev_bk = -1, prev_c = -100;
    for (int t = t0; t < t1; ++t) {
        const int c = t & 31, bk = t >> 5, kvh = bk & 3, b = bk >> 2;
        const bool cont = (bk == prev_bk) && (c == prev_c + 1);
        const bf16_t* Pk = P + ((size_t)b * 2048 + jk) * DPROJ + O_K + kvh * 64 + chk * 8;
        const bf16_t* Pv = P + ((size_t)b * 2048 + jv) * DPROJ + O_V + kvh * 64 + chv * 8;
        if (cont) {
            const int slot = c % 3;
            *(LAS u32x4*)(KS + (slot * 64 + jk) * 72 + chk * 8) = pk;
#pragma unroll
            for (int e = 0; e < 4; ++e) { VT[(chv * 8 + 2 * e) * 200 + slot * 64 + jv] = (bf16_t)(pv[e] & 0xffffu); VT[(chv * 8 + 2 * e + 1) * 200 + slot * 64 + jv] = (bf16_t)(pv[e] >> 16); }
        } else {
            for (int q = (c >= 2 ? c - 2 : 0); q <= c; ++q) {
                const int slot = q % 3;
                const u32x4 wk = *(const u32x4*)(Pk + (size_t)q * 64 * DPROJ), wv = *(const u32x4*)(Pv + (size_t)q * 64 * DPROJ);
                *(LAS u32x4*)(KS + (slot * 64 + jk) * 72 + chk * 8) = wk;
#pragma unroll
                for (int e = 0; e < 4; ++e) { VT[(chv * 8 + 2 * e) * 200 + slot * 64 + jv] = (bf16_t)(wv[e] & 0xffffu); VT[(chv * 8 + 2 * e + 1) * 200 + slot * 64 + jv] = (bf16_t)(wv[e] >> 16); }
            }
        }
        __syncthreads();
        {
            const int g = wave >> 1, qh = wave & 1;
            const int head = kvh * 4 + g, i = 32 * qh + r;
            const size_t qrow = (size_t)b * 2048 + c * 64 + i;
            const bf16_t* qp = P + qrow * DPROJ + O_Q + head * 64 + 8 * h;
            bf16x8 qf[4];
            if (cont) {
#pragma unroll
                for (int s = 0; s < 4; ++s) qf[s] = qn[s];
            } else {
#pragma unroll
                for (int s = 0; s < 4; ++s) qf[s] = *(const bf16x8*)(qp + 16 * s);
            }
            if (t + 1 < t1 && ((t + 1) >> 5) == bk) {
                pk = *(const u32x4*)(Pk + (size_t)(c + 1) * 64 * DPROJ); pv = *(const u32x4*)(Pv + (size_t)(c + 1) * 64 * DPROJ);
#pragma unroll
                for (int s = 0; s < 4; ++s) qn[s] = *(const bf16x8*)(qp + (size_t)64 * DPROJ + 16 * s);
            }
            const bf16_t* gp = P + qrow * DPROJ + O_GA + head * 64 + 8 * h;
            u32x4 gwv[4];
#pragma unroll
            for (int e = 0; e < 4; ++e) gwv[e] = *(const u32x4*)(gp + 16 * e);
            const int T0 = c >= 2 ? 0 : 2 * (2 - c);
            const int sl0 = (c + 1) % 3, sl1 = (c + 2) % 3, sl2 = c % 3;
            f32x16 st[6];
#pragma unroll
            for (int T = 0; T < 6; ++T) {
                f32x16 acc;
                const int prow = 64 * ((T >> 1) == 0 ? sl0 : ((T >> 1) == 1 ? sl1 : sl2)) + 32 * (T & 1);
                if (T >= T0) {
#pragma unroll
                    for (int e = 0; e < 16; ++e) acc[e] = 0.f;
#pragma unroll
                    for (int s = 0; s < 4; ++s) { const bf16x8 a = *(const LAS bf16x8*)(KS + (prow + r) * 72 + 16 * s + 8 * h); acc = MFMA32(a, qf[s], acc); }
                } else {
#pragma unroll
                    for (int e = 0; e < 16; ++e) acc[e] = -1e30f;
                }
                st[T] = acc;
            }
            const float sc = 0.125f * LOG2E;
            const LAS float* bl = BIAS + head * 256 + 63 - i + 4 * h;
            float mx = -3e38f;
#pragma unroll
            for (int T = 0; T < 6; ++T)
                if (T >= T0) {
#pragma unroll
                    for (int e = 0; e < 16; ++e) { const float v = st[T][e] * sc + bl[32 * T + (e & 3) + 8 * (e >> 2)]; st[T][e] = v; mx = fmaxf(mx, v); }
                }
            mx = fmaxf(mx, __shfl_xor(mx, 32));
            const float sink2 = p.sinks[l * 16 + head] * LOG2E;
            mx = fmaxf(mx, sink2);
            float sum = 0.f;
#pragma unroll
            for (int T = 0; T < 6; ++T)
#pragma unroll
                for (int e = 0; e < 16; ++e) { const float pe = __builtin_amdgcn_exp2f(st[T][e] - mx); st[T][e] = pe; sum += pe; }
            sum += __shfl_xor(sum, 32);
            sum += __builtin_amdgcn_exp2f(sink2 - mx);
            const float inv = 1.0f / sum;
            f32x16 o[2];
#pragma unroll
            for (int e = 0; e < 16; ++e) { o[0][e] = 0.f; o[1][e] = 0.f; }
#pragma unroll
            for (int T = 0; T < 6; ++T)
                if (T >= T0) {
                    const int prow = 64 * ((T >> 1) == 0 ? sl0 : ((T >> 1) == 1 ? sl1 : sl2)) + 32 * (T & 1);
#pragma unroll
                    for (int s = 0; s < 2; ++s) {
                        const bf16x8 xs = pack_step(st[T], s);
#pragma unroll
                        for (int dt = 0; dt < 2; ++dt) {
                            const LAS bf16_t* vp = VT + (32 * dt + r) * 200 + prow + 16 * s + 4 * h;
                            const s16x4 lo = *(const LAS s16x4*)vp, hi = *(const LAS s16x4*)(vp + 8);
                            const bf16x8 pa = __builtin_shufflevector(lo, hi, 0, 1, 2, 3, 4, 5, 6, 7);
                            o[dt] = MFMA32(pa, xs, o[dt]);
                        }
                    }
                }
            float ss = 0.f;
            bf16_t* yp = Y + qrow * DM + head * 64 + 8 * h;
#pragma unroll
            for (int dt = 0; dt < 2; ++dt)
#pragma unroll
                for (int pr = 0; pr < 2; ++pr) {
                    float a[4], bq[4];
#pragma unroll
                    for (int k = 0; k < 4; ++k) { a[k] = o[dt][8 * pr + k] * inv; bq[k] = o[dt][8 * pr + 4 + k] * inv; }
                    ss += ((a[0] * a[0] + a[1] * a[1]) + (a[2] * a[2] + a[3] * a[3])) + ((bq[0] * bq[0] + bq[1] * bq[1]) + (bq[2] * bq[2] + bq[3] * bq[3]));
#pragma unroll
                    for (int k = 0; k < 4; ++k) swap_halves(a[k], bq[k]);
                    const u32x4 gw = gwv[2 * dt + pr];
                    u32x4 w; w.x = pk2(a[0] * bf_lo(gw.x), a[1] * bf_hi(gw.x)); w.y = pk2(a[2] * bf_lo(gw.y), a[3] * bf_hi(gw.y));
                    w.z = pk2(bq[0] * bf_lo(gw.z), bq[1] * bf_hi(gw.z)); w.w = pk2(bq[2] * bf_lo(gw.w), bq[3] * bf_hi(gw.w));
                    *(u32x4*)(yp + 32 * dt + 16 * pr) = w;
                }
            ss += __shfl_xor(ss, 32);
            if (h == 0) ssa[qrow * 16 + head] = ss;
        }
        __syncthreads();
        prev_bk = bk; prev_c = c;
    }
}

__device__ __forceinline__ int vgt_off(int sidx) { return sidx * 18432; }
__device__ __forceinline__ void gmlp_task(LAS unsigned char* lds, const Params& p, const bf16_t* P, bf16_t* Y, const float* svg, float* ssb, int l, bool sample, int b, int g, int q, int tid, int wave, int lane, bool load_ws = true) {
    lane = lane_fresh(); tid = wave * 64 + lane;
    LAS bf16_t* WSL = (LAS bf16_t*)(lds + L_WS);
    LAS f32x2* MUR = (LAS f32x2*)(lds + L_MUR);
    if (load_ws) {
        const float* wsp = p.w_spatial + (size_t)(l * 16 + g) * 128 * 128;
#pragma unroll
        for (int k = 0; k < 4; ++k) {
            const int id = tid + 512 * k, i = id >> 4, j0 = (id & 15) * 8;
            f32x4 a = *(const f32x4*)(wsp + i * 128 + j0), bb = *(const f32x4*)(wsp + i * 128 + j0 + 4);
#pragma unroll
            for (int e = 0; e < 4; ++e) { if (j0 + e > i) a[e] = 0.f; if (j0 + 4 + e > i) bb[e] = 0.f; }
            *(LAS u32x4*)(WSL + i * 136 + j0) = pack8(a, bb);
        }
    }
    const int L = sample ? 32 : 128;
    const int r = lane & 31, h = lane >> 5;
    const float* lg = p.ln_v_g + l * 1024 + g * 64; const float* lb = p.ln_v_b + l * 1024 + g * 64;
    u32x4 wraw[4][2];
#pragma unroll
    for (int sub = 0; sub < 4; ++sub) {
        const int cidx = q * 4 + sub;
        const size_t row0 = sample ? (size_t)NP + cidx * 32 : (size_t)b * 2048 + cidx * 128;
#pragma unroll
        for (int k = 0; k < 2; ++k) {
            const int id = tid + 512 * k;
            if (id < L * 8) { const int ch = id & 7, j = id >> 3; wraw[sub][k] = *(const u32x4*)(P + (row0 + j) * DPROJ + O_VG + g * 64 + ch * 8); }
            else wraw[sub][k] = (u32x4){0u, 0u, 0u, 0u};
        }
    }
#pragma unroll
    for (int sub = 0; sub < 4; ++sub) {
        const int cidx = q * 4 + sub;
        const size_t row0 = sample ? (size_t)NP + cidx * 32 : (size_t)b * 2048 + cidx * 128;
        if ((tid >> 2) < L) {
            const int j = tid >> 2, qq = tid & 3;
            const f32x4* sp = (const f32x4*)(svg + ((row0 + j) * 16 + qq * 4) * 2);
            const f32x4 a = sp[0], bq = sp[1];
            float s1 = (a[0] + a[2]) + (bq[0] + bq[2]), s2 = (a[1] + a[3]) + (bq[1] + bq[3]);
            s1 += __shfl_xor(s1, 1); s1 += __shfl_xor(s1, 2); s2 += __shfl_xor(s2, 1); s2 += __shfl_xor(s2, 2);
            const float mean = s1 * (1.0f / 1024.0f), var = s2 * (1.0f / 1024.0f) - mean * mean;
            if (qq == 0) MUR[sub * 128 + j] = (f32x2){mean, __builtin_amdgcn_rsqf(var + EPS)};
        }
    }
    __syncthreads();
#pragma unroll
    for (int sub = 0; sub < 4; ++sub) {
        const int cidx = q * 4 + sub;
        const size_t row0 = sample ? (size_t)NP + cidx * 32 : (size_t)b * 2048 + cidx * 128;
        LAS bf16_t* VGT = (LAS bf16_t*)(lds + vgt_off(sub));
#pragma unroll
        for (int k = 0; k < 2; ++k) {
            const int id = tid + 512 * k;
            if (id >= L * 8) continue;
            const int ch = id & 7, j = id >> 3;
            const f32x2 mr = MUR[sub * 128 + j];
            const float mean = mr.x, rstd = mr.y;
            const u32x4 w = wraw[sub][k];
            const f32x4 g0 = *(const f32x4*)(lg + ch * 8), g1 = *(const f32x4*)(lg + ch * 8 + 4), b0 = *(const f32x4*)(lb + ch * 8), b1 = *(const f32x4*)(lb + ch * 8 + 4);
            f32x4 v0 = (f32x4){bf_lo(w.x), bf_hi(w.x), bf_lo(w.y), bf_hi(w.y)}, v1 = (f32x4){bf_lo(w.z), bf_hi(w.z), bf_lo(w.w), bf_hi(w.w)};
            v0 = (v0 - mean) * rstd * g0 + b0; v1 = (v1 - mean) * rstd * g1 + b1;
            if (sample) { float* dst = p.out + OUT_VGS + ((((size_t)l * 32 + cidx) * 32 + j) * 16 + g) * 64 + ch * 8; *(f32x4*)dst = v0; *(f32x4*)(dst + 4) = v1; }
            *(LAS u32x4*)(VGT + j * 72 + ch * 8) = pack8(v0, v1);
        }
    }
    __syncthreads();
    const int it = sample ? 0 : (wave >> 1), dt = wave & 1;
    const bool active = sample ? (wave < 2) : true;
    if (active) {
        const int i = 32 * it + r;
        const float bias = p.b_spatial[(l * 16 + g) * 128 + i];
        const int nks = 2 * (it + 1);
#pragma unroll
        for (int sub = 0; sub < 4; ++sub) {
            const int cidx = q * 4 + sub;
            const size_t row0 = sample ? (size_t)NP + cidx * 32 : (size_t)b * 2048 + cidx * 128;
            const LAS bf16_t* VGT = (const LAS bf16_t*)(lds + vgt_off(sub));
            const size_t row = row0 + i;
            const bf16_t* up = P + row * DPROJ + O_U + g * 64 + 32 * dt + 8 * h;
            const bf16_t* gp = P + row * DPROJ + O_GB + g * 64 + 32 * dt + 8 * h;
            u32x4 uw[2], gw[2];
#pragma unroll
            for (int pr = 0; pr < 2; ++pr) { uw[pr] = *(const u32x4*)(up + 16 * pr); gw[pr] = *(const u32x4*)(gp + 16 * pr); }
            f32x16 acc;
#pragma unroll
            for (int e = 0; e < 16; ++e) acc[e] = 0.f;
            const LAS bf16_t* tr = VGT + (8 * h + ((lane & 15) >> 2)) * 72 + 32 * dt + 16 * ((lane >> 4) & 1) + 4 * (lane & 3);
            for (int ks = 0; ks < nks; ++ks) {
                const s16x4 alo = __builtin_amdgcn_ds_read_tr16_b64_v4i16((LAS s16x4*)(tr + 16 * ks * 72)), ahi = __builtin_amdgcn_ds_read_tr16_b64_v4i16((LAS s16x4*)(tr + (16 * ks + 4) * 72));
                const bf16x8 a = __builtin_shufflevector(alo, ahi, 0, 1, 2, 3, 4, 5, 6, 7);
                const bf16x8 bw = *(const LAS bf16x8*)(WSL + (32 * it + r) * 136 + 16 * ks + 8 * h);
                acc = MFMA32(a, bw, acc);
            }
            bf16_t* yp = Y + row * DM + 1024 + g * 64 + 32 * dt + 8 * h;
            float ss = 0.f;
#pragma unroll
            for (int pr = 0; pr < 2; ++pr) {
                float a[4], bq[4];
#pragma unroll
                for (int k = 0; k < 4; ++k) { a[k] = acc[8 * pr + k] + bias; bq[k] = acc[8 * pr + 4 + k] + bias; }
#pragma unroll
                for (int k = 0; k < 4; ++k) swap_halves(a[k], bq[k]);
                const u32x4 u4 = uw[pr], g4 = gw[pr];
                a[0] *= bf_lo(u4.x); a[1] *= bf_hi(u4.x); a[2] *= bf_lo(u4.y); a[3] *= bf_hi(u4.y); bq[0] *= bf_lo(u4.z); bq[1] *= bf_hi(u4.z); bq[2] *= bf_lo(u4.w); bq[3] *= bf_hi(u4.w);
                ss += ((a[0] * a[0] + a[1] * a[1]) + (a[2] * a[2] + a[3] * a[3])) + ((bq[0] * bq[0] + bq[1] * bq[1]) + (bq[2] * bq[2] + bq[3] * bq[3]));
                u32x4 w; w.x = pk2(a[0] * bf_lo(g4.x), a[1] * bf_hi(g4.x)); w.y = pk2(a[2] * bf_lo(g4.y), a[3] * bf_hi(g4.y));
                w.z = pk2(bq[0] * bf_lo(g4.z), bq[1] * bf_hi(g4.z)); w.w = pk2(bq[2] * bf_lo(g4.w), bq[3] * bf_hi(g4.w));
                *(u32x4*)(yp + 16 * pr) = w;
            }
            ss += __shfl_xor(ss, 32);
            if (h == 0) ssb[row * 32 + g * 2 + dt] = ss;
        }
    }
    __syncthreads();
}

#define XB_TMO      128
#define XB_XCNT(j)  (256  + 64 * (j))
#define XB_XSUB(j)  (1280 + 64 * (j))
#define XB_XGEN(j)  (2304 + 64 * (j))
#define XB_TOP      3328
#define XB_TOPGEN   3392
#define XCD_BAR_WORDS 3456
#define XB_SPIN_CAP (1u << 18)

__device__ __forceinline__ unsigned xb_ld(unsigned* p)              { return __hip_atomic_load(p, __ATOMIC_RELAXED, __HIP_MEMORY_SCOPE_AGENT); }
__device__ __forceinline__ unsigned xb_add(unsigned* p, unsigned v) { return __hip_atomic_fetch_add(p, v, __ATOMIC_RELAXED, __HIP_MEMORY_SCOPE_AGENT); }
__device__ __forceinline__ unsigned xb_xcc_id() { return (unsigned)__builtin_amdgcn_s_getreg((3 << 11) | 20) & 0xFu; }
#define XB_SPIN(cond, bar) do { unsigned _sp = 0; while (cond) { __builtin_amdgcn_s_sleep(1); \
    if ((++_sp & 255u) == 0u) { if (xb_ld(&(bar)[XB_TMO])) break; if (_sp > XB_SPIN_CAP) { atomicAdd(&(bar)[XB_TMO], 1u); break; } } } } while (0)

struct XcdBarrier {
    unsigned* bar; unsigned x;
    volatile LAS unsigned* st;
};

__device__ __forceinline__ XcdBarrier xcd_barrier_post(unsigned* bar, volatile LAS unsigned* st) {
    XcdBarrier b; b.bar = bar; b.x = xb_xcc_id(); b.st = st;
    if (threadIdx.x == 0) (void)xb_add(&bar[XB_XCNT(b.x)], 1u);
    return b;
}
__device__ __forceinline__ void xcd_barrier_complete(unsigned* bar, unsigned x, unsigned& nloc, unsigned& nx) {
    const unsigned G = gridDim.x * gridDim.y * gridDim.z;
    unsigned sum, cnt, mine, sp = 0u;
    for (;;) {
        sum = 0u; cnt = 0u; mine = 0u;
#pragma unroll
        for (unsigned j = 0; j < 16; ++j) { const unsigned c = xb_ld(&bar[XB_XCNT(j)]); sum += c; cnt += (c > 0u) ? 1u : 0u; mine = (j == x) ? c : mine; }
        if (sum == G) break;
        __builtin_amdgcn_s_sleep(1);
        if ((++sp & 255u) == 0u) { if (xb_ld(&bar[XB_TMO])) break; if (sp > XB_SPIN_CAP) { atomicAdd(&bar[XB_TMO], 1u); break; } }
    }
    nloc = mine > 0u ? mine : 1u; nx = cnt > 0u ? cnt : 1u;
}

__device__ __forceinline__ void xcd_barrier(const XcdBarrier& b) {
    asm volatile("s_waitcnt vmcnt(0)" ::: "memory");
    __syncthreads();
    if (threadIdx.x == 0) {
        unsigned* bar = b.bar;
        __builtin_amdgcn_s_waitcnt(0);
        unsigned nloc = b.st[0], nx = b.st[1];
        if (nloc == 0u) { xcd_barrier_complete(bar, b.x, nloc, nx); b.st[0] = nloc; b.st[1] = nx; }
        const unsigned old = xb_add(&bar[XB_XSUB(b.x)], 1u);
        const unsigned gen = old / nloc;
        if (old + 1u == (gen + 1u) * nloc) {
            __builtin_amdgcn_fence(__ATOMIC_RELEASE, "agent");
            asm volatile("s_waitcnt vmcnt(0)" ::: "memory");
            const unsigned og = xb_add(&bar[XB_TOP], 1u);
            const unsigned tg = og / nx;
            if (og + 1u == (tg + 1u) * nx) xb_add(&bar[XB_TOPGEN], 1u);
            else XB_SPIN(xb_ld(&bar[XB_TOPGEN]) == tg, bar);
            __builtin_amdgcn_fence(__ATOMIC_ACQUIRE, "agent");
            xb_add(&bar[XB_XGEN(b.x)], 1u);
            asm volatile("s_waitcnt vmcnt(0)" ::: "memory");
        } else {
            XB_SPIN(xb_ld(&bar[XB_XGEN(b.x)]) == gen, bar);
            __builtin_amdgcn_fence(__ATOMIC_ACQUIRE, "agent");
            asm volatile("s_waitcnt vmcnt(0)" ::: "memory");
        }
    }
    __syncthreads();
}


struct OneUnit { int pm, pn; __device__ bool next(int i, pg8::Unit& u) const { if (i != 0) return false; u.pm = pm; u.pn = pn; return true; } };

template <class Sched>
__device__ __forceinline__ void run_in_proj(LAS unsigned char* lds, const Params& p, int l, const Sched& S, int M, int rows_off, int wave, int stage_off = -1) {
    unsigned char* ws = p.ws;
    const float* SSX = (const float*)(ws + WS_SSX);
    {
        const int ln = lane_fresh(), t = wave * 64 + ln, r = t >> 1, hf = t & 1;
        LAS float* rows = (LAS float*)(lds + rows_off); pg8::Unit u;
        for (int i = 0; i < 12 && S.next(i, u); ++i) {
            const f32x4* sp = (const f32x4*)(SSX + ((size_t)u.pm * 256 + r) * 32 + hf * 16);
            float sm = (sum4(sp[0]) + sum4(sp[1])) + (sum4(sp[2]) + sum4(sp[3]));
            sm += __shfl_xor(sm, 1);
            if (hf == 0) rows[i * 256 + r] = __builtin_amdgcn_rsqf(sm * (1.0f / 2048.0f) + EPS);
        }
        __syncthreads();
    }
    pg8::Gemm g{(const bf16_t*)(ws + WS_XB), (const bf16_t*)(ws + WS_WIN) + (size_t)l * DPROJ * DM, M, DPROJ, DM};
    EpiIn E{(bf16_t*)(ws + WS_P), (const LAS float*)(lds + rows_off), (float*)(ws + WS_SVG), p.out + OUT_KNP + (size_t)l * 524288, p.out + OUT_NVP + (size_t)l * 524288, p.out + OUT_NKS + (size_t)l * 1048576, p.out + OUT_NVS + (size_t)l * 1048576,
            stage_off >= 0 ? lds + stage_off : (LAS unsigned char*)nullptr};
    pg8::gemm_phase<EpiIn, Sched>(lds, g, S, E, wave);
}
template <class Sched>
__device__ __forceinline__ void run_out_proj(LAS unsigned char* lds, const Params& p, int l, const Sched& S, int M, int rows_off, int wave, int stage_off = -1) {
    unsigned char* ws = p.ws;
    const float* SSA = (const float*)(ws + WS_SSA); const float* SSB = (const float*)(ws + WS_SSB);
    {
        const int ln = lane_fresh(), t = wave * 64 + ln, r = t >> 1, hf = t & 1;
        LAS float* rows = (LAS float*)(lds + rows_off); pg8::Unit u;
        for (int i = 0; i < 10 && S.next(i, u); ++i) {
            const size_t row = (size_t)u.pm * 256 + r;
            const f32x4* ap = (const f32x4*)(SSA + row * 16 + hf * 8); const f32x4* bp = (const f32x4*)(SSB + row * 32 + hf * 16);
            float sa = sum4(ap[0]) + sum4(ap[1]), sb = (sum4(bp[0]) + sum4(bp[1])) + (sum4(bp[2]) + sum4(bp[3]));
            sa += __shfl_xor(sa, 1); sb += __shfl_xor(sb, 1);
            const float a = sa * (1.0f / 1024.0f) + EPS, b = sb * (1.0f / 1024.0f) + EPS;
            if (hf == 0) { rows[i * 768 + r] = __builtin_sqrtf(a); rows[i * 768 + 256 + r] = __builtin_amdgcn_rsqf(a) * __builtin_sqrtf(b); rows[i * 768 + 512 + r] = __builtin_amdgcn_rsqf(b); }
        }
        __syncthreads();
    }
    pg8::Gemm g{(const bf16_t*)(ws + WS_Y), (const bf16_t*)(ws + WS_WOUT) + (size_t)l * DM * DM, M, DM, DM};
    EpiOut E{p.out, (bf16_t*)(ws + WS_XB), (float*)(ws + WS_SSX), (const LAS float*)(lds + rows_off), 0, stage_off >= 0 ? lds + stage_off : (LAS unsigned char*)nullptr};
    pg8::gemm_phase<EpiOut, Sched>(lds, g, S, E, wave);
}

__device__ __forceinline__ void block_arrive(unsigned* cnt) {
    asm volatile("s_waitcnt vmcnt(0)" ::: "memory");
    __syncthreads();
    if (threadIdx.x == 0) { __builtin_amdgcn_fence(__ATOMIC_RELEASE, "agent"); asm volatile("s_waitcnt vmcnt(0)" ::: "memory"); (void)__hip_atomic_fetch_add(cnt, 1u, __ATOMIC_RELAXED, __HIP_MEMORY_SCOPE_AGENT); }
}
__device__ __forceinline__ void block_wait(unsigned* cnt, unsigned want) {
    if (threadIdx.x == 0) {
        unsigned spins = 0;
        while (__hip_atomic_load(cnt, __ATOMIC_RELAXED, __HIP_MEMORY_SCOPE_AGENT) < want) { __builtin_amdgcn_s_sleep(4); if (++spins > (1u << 24)) break; }
        __builtin_amdgcn_fence(__ATOMIC_ACQUIRE, "agent"); asm volatile("s_waitcnt vmcnt(0)" ::: "memory");
    }
    __syncthreads();
}

__device__ __forceinline__ void p2_phase(LAS unsigned char* lds, const Params& p, int l, int tid, int wave, int lane, int bid, int G) {
    lane = lane_fresh(); tid = wave * 64 + lane;
    unsigned char* ws = p.ws;
    const bf16_t* P = (const bf16_t*)(ws + WS_P); bf16_t* Y = (bf16_t*)(ws + WS_Y);
    const float* SVG = (const float*)(ws + WS_SVG); float* SSA = (float*)(ws + WS_SSA); float* SSB = (float*)(ws + WS_SSB);
    unsigned* CNT = (unsigned*)(ws + WS_CNT) + l * 512;
    LAS float* BIAS = (LAS float*)(lds + L_BIAS);
    for (int id = tid; id < 16 * 256; id += 512) {
        const int hh = id >> 8, idx = id & 255, rel = idx - 191, n = rel < 0 ? -rel : rel;
        int bk = n; if (n >= 8) { bk = 33 - __builtin_clz((unsigned)(n * n)); if (bk > 15) bk = 15; }
        bk += (rel > 0) ? 16 : 0;
        BIAS[id] = p.rel_bias[bk * 16 + hh] * LOG2E;
    }
    __syncthreads();
    if (bid < 128) attn_task(lds, p, P, Y, SSA, l, true, bid >> 2, 0, bid & 3, tid, wave, lane);
    else { const int u = bid - 128; gmlp_task(lds, p, P, Y, SVG, SSB, l, true, 0, u >> 3, u & 7, tid, wave, lane); }
    block_arrive(CNT);
    const int ngemm = (l < DEPTH - 1) ? 120 : 32;
    int start, count;
    if (bid < ngemm) { start = bid * 10; count = 10; }
    else { const int rest = 3072 - ngemm * 10, nb = 256 - ngemm, q = rest / nb, rem = rest - q * nb, j = bid - ngemm; start = ngemm * 10 + j * q + (j < rem ? j : rem); count = q + (j < rem ? 1 : 0); }
    const int end = start + count;
    const int ta0 = 2 * (start / 3) + (start % 3 < 2 ? start % 3 : 2), ta1 = 2 * (end / 3) + (end % 3 < 2 ? end % 3 : 2), ug0 = start / 3, ug1 = end / 3;
    const int tsplit = (bid < 32) ? (ta0 + 2 < ta1 ? ta0 + 2 : ta1) : ta1;
    attn_run(lds, p, P, Y, SSA, l, ta0, tsplit, wave);
    if (bid < 32) {
        block_wait(CNT, 256u);
        OneUnit S{128 + (bid >> 3), bid & 7};
        run_out_proj<OneUnit>(lds, p, l, S, MT, L_ROWS + 16384, wave);
        block_arrive(CNT + 64 * (1 + (bid >> 3)));
    }
    attn_run(lds, p, P, Y, SSA, l, tsplit, ta1, wave);
    for (int u = ug0; u < ug1; ++u)
        gmlp_task(lds, p, P, Y, SVG, SSB, l, false, (u >> 2) & 15, u >> 6, u & 3, tid, wave, lane, u == ug0 || (u >> 6) != ((u - 1) >> 6));
    if (bid >= 32 && bid < ngemm) {
        const int idx = bid - 32, tile = idx / 22;
        block_wait(CNT + 64 * (1 + tile), 8u);
        OneUnit S{128 + tile, idx - tile * 22};
        run_in_proj<OneUnit>(lds, p, l + 1, S, MT, L_ROWS + 16384, wave);
    }
}

__global__ void __launch_bounds__(512, 2) fwd_megakernel(Params p) {
    extern __shared__ __attribute__((aligned(16))) unsigned char lds_raw[];
    LAS unsigned char* lds = (LAS unsigned char*)lds_raw;
    cg::grid_group grid = cg::this_grid();
    const int wave = __builtin_amdgcn_readfirstlane(threadIdx.x >> 6), tid = 0, lane = 0, G = gridDim.x, bid = blockIdx.x;
    unsigned char* ws = p.ws;
    float* SSX = (float*)(ws + WS_SSX);

    {
        volatile LAS unsigned* st = (volatile LAS unsigned*)(lds + LDS_BYTES - 64);
        if (threadIdx.x < 2) st[threadIdx.x] = 0u;
        __syncthreads();
    }
    const XcdBarrier xbar = xcd_barrier_post((unsigned*)(ws + WS_CNT) + 4096, (volatile LAS unsigned*)(lds + LDS_BYTES - 64));
    prologue(lds, p, tid, wave, lane, bid, G);
    grid.sync();
#pragma unroll 1
    for (int l = 0; l < DEPTH; ++l) {
        {
            const int M = (l == 0) ? MT : NP;
            pg8::StaticOrder S; S.init(M, DPROJ, G, bid);
            run_in_proj<pg8::StaticOrder>(lds, p, l, S, M, L_ROWS, wave, L_ROWS + 12288);
        }
        xcd_barrier(xbar);
        p2_phase(lds, p, l, tid, wave, lane, bid, G);
        xcd_barrier(xbar);
        {
            pg8::StaticOrder S; S.init(NP, DM, G, bid);
            run_out_proj<pg8::StaticOrder>(lds, p, l, S, NP, L_ROWS, wave, L_ROWS + 12288);
        }
        xcd_barrier(xbar);
    }
    {
        const int ll = lane_fresh();
        const int gw = bid * 8 + wave, NGW = G * 8;
        const f32x4* gf = (const f32x4*)p.norm_final + ll;
        const bf16_t* XBf = (const bf16_t*)(ws + WS_XB);
        f32x4 gv[8];
#pragma unroll
        for (int j = 0; j < 8; ++j) gv[j] = gf[64 * j];
        for (int row = gw; row < MT; row += 2 * NGW) {
            const int row2 = row + NGW; const bool two = row2 < MT; const int rb = two ? row2 : row;
            const u32x2* xa = (const u32x2*)(XBf + (size_t)row * DM) + ll; const u32x2* xb2 = (const u32x2*)(XBf + (size_t)rb * DM) + ll;
            u32x2 wa[8], wb[8];
#pragma unroll
            for (int j = 0; j < 8; ++j) wa[j] = xa[64 * j];
#pragma unroll
            for (int j = 0; j < 8; ++j) wb[j] = xb2[64 * j];
            const float pa = ll < 32 ? SSX[(size_t)row * 32 + ll] : 0.f, pb = ll < 32 ? SSX[(size_t)rb * 32 + ll] : 0.f;
            const float ra = __builtin_amdgcn_rsqf(wave_sum(pa) * (1.0f / 2048.0f) + EPS), rbs = __builtin_amdgcn_rsqf(wave_sum(pb) * (1.0f / 2048.0f) + EPS);
            f32x4* oa = (f32x4*)(p.out + (size_t)row * DM) + ll; f32x4* ob = (f32x4*)(p.out + (size_t)rb * DM) + ll;
#pragma unroll
            for (int j = 0; j < 8; ++j) { const u32x2 w = wa[j]; oa[64 * j] = (f32x4){bf_lo(w.x), bf_hi(w.x), bf_lo(w.y), bf_hi(w.y)} * ra * gv[j]; }
            if (two) {
#pragma unroll
                for (int j = 0; j < 8; ++j) { const u32x2 w = wb[j]; ob[64 * j] = (f32x4){bf_lo(w.x), bf_hi(w.x), bf_lo(w.y), bf_hi(w.y)} * rbs * gv[j]; }
            }
        }
    }
}

extern "C" void kernel_launch(void* const* d_in, const int* in_sizes, int n_in, void* d_out, int out_size, void* d_ws, size_t ws_size, hipStream_t stream) {
    static int grid = 0;
    if (grid == 0) {
        if (n_in != 16 || ws_size < WS_END) { fprintf(stderr, "kernel_launch: unexpected n_in %d / ws_size %zu\n", n_in, ws_size); grid = -1; return; }
        int dev = 0, cus = 0, per_cu = 0;
        hipGetDevice(&dev);
        hipDeviceGetAttribute(&cus, hipDeviceAttributeMultiprocessorCount, dev);
        hipFuncSetAttribute((const void*)fwd_megakernel, hipFuncAttributeMaxDynamicSharedMemorySize, LDS_BYTES);
        hipOccupancyMaxActiveBlocksPerMultiprocessor(&per_cu, (const void*)fwd_megakernel, 512, LDS_BYTES);
        if (per_cu < 1) per_cu = 1;
        (void)hipGetLastError();
        grid = cus * per_cu;
        if (grid != 256) { fprintf(stderr, "kernel_launch: this kernel's phase-2 schedule is built for a 256-workgroup grid, got %d\n", grid); grid = -1; return; }
    }
    if (grid < 0) return;
    Params p{};
    p.x_prompt = (const float*)d_in[0]; p.x_sample = (const float*)d_in[1]; p.cache_k = (const float*)d_in[2]; p.cache_v = (const float*)d_in[3];
    p.w_in = (const float*)d_in[4]; p.w_out = (const float*)d_in[5]; p.norm_in = (const float*)d_in[6]; p.rel_bias = (const float*)d_in[7]; p.sinks = (const float*)d_in[8];
    p.norm_attn = (const float*)d_in[9]; p.norm_gmlp = (const float*)d_in[10]; p.ln_v_g = (const float*)d_in[11]; p.ln_v_b = (const float*)d_in[12];
    p.w_spatial = (const float*)d_in[13]; p.b_spatial = (const float*)d_in[14]; p.norm_final = (const float*)d_in[15];
    p.out = (float*)d_out; p.ws = (unsigned char*)d_ws;
    (void)hipMemsetAsync((unsigned char*)d_ws + WS_CNT, 0, 65536, stream);
    void* args[] = {&p};
    hipError_t e = hipLaunchCooperativeKernel((const void*)fwd_megakernel, dim3(grid), dim3(512), args, LDS_BYTES, stream);
    if (e != hipSuccess) fprintf(stderr, "cooperative launch failed: %s (grid %d)\n", hipGetErrorString(e), grid);
}
```

```cpp
#include <hip/hip_runtime.h>
#include <hip/hip_cooperative_groups.h>
#include <cstdio>
#include <cstdint>
namespace cg = cooperative_groups;

#define LAS __attribute__((address_space(3)))
typedef unsigned short bf16_t;
typedef short bf16x8 __attribute__((ext_vector_type(8)));
typedef short s16x4 __attribute__((ext_vector_type(4)));
typedef float f32x4 __attribute__((ext_vector_type(4)));
typedef float f32x2 __attribute__((ext_vector_type(2)));
typedef float f32x16 __attribute__((ext_vector_type(16)));
typedef unsigned u32x4 __attribute__((ext_vector_type(4)));
typedef unsigned u32x2 __attribute__((ext_vector_type(2)));

constexpr int DM = 2048, NP = 16 * 2048, NS = 32 * 32, MT = NP + NS, DPROJ = 5632, DEPTH = 4;
constexpr int O_Q = 0, O_K = 1024, O_V = 1280, O_GA = 1536, O_U = 2560, O_VG = 3584, O_GB = 4608;
constexpr float EPS = 1e-6f, LOG2E = 1.4426950408889634f;
constexpr size_t OUT_KNP = (size_t)MT * DM, OUT_NVP = OUT_KNP + 2097152, OUT_NKS = OUT_NVP + 2097152, OUT_NVS = OUT_NKS + 4194304, OUT_VGS = OUT_NVS + 4194304;
constexpr size_t MiB = 1u << 20;
constexpr size_t WS_WIN = 0, WS_WOUT = 88 * MiB, WS_XB = 120 * MiB, WS_P = 252 * MiB, WS_Y = 616 * MiB, WS_SSX = 748 * MiB, WS_SVG = 753 * MiB, WS_SSA = 758 * MiB, WS_SSB = 761 * MiB, WS_CNT = 766 * MiB, WS_END = 767 * MiB;
static_assert((size_t)DEPTH * DPROJ * DM * 2 <= WS_WOUT && WS_WOUT + (size_t)DEPTH * DM * DM * 2 <= WS_XB && WS_XB + (size_t)MT * DM * 2 <= WS_P && WS_P + (size_t)MT * DPROJ * 2 <= WS_Y && WS_Y + (size_t)MT * DM * 2 <= WS_SSX, "ws map");
constexpr int LDS_BYTES = 163840, L_ROWS = 131072;

struct Params {
    const float *x_prompt, *x_sample, *cache_k, *cache_v, *w_in, *w_out, *norm_in, *rel_bias, *sinks, *norm_attn, *norm_gmlp, *ln_v_g, *ln_v_b, *w_spatial, *b_spatial, *norm_final;
    float* out; unsigned char* ws;
};

__device__ __forceinline__ unsigned f2bf(float f) { unsigned u = __builtin_bit_cast(unsigned, f); return (u + 0x7fffu + ((u >> 16) & 1u)) >> 16; }
typedef __bf16 bf16x2_t __attribute__((ext_vector_type(2)));
__device__ __forceinline__ unsigned pk2(float lo, float hi) { const f32x2 v = {lo, hi}; return __builtin_bit_cast(unsigned, __builtin_convertvector(v, bf16x2_t)); }
__device__ __forceinline__ float bf_lo(unsigned w) { return __builtin_bit_cast(float, w << 16); }
__device__ __forceinline__ float bf_hi(unsigned w) { return __builtin_bit_cast(float, w & 0xffff0000u); }
__device__ __forceinline__ float wave_sum(float v) {
#pragma unroll
    for (int o = 1; o < 64; o <<= 1) v += __shfl_xor(v, o);
    return v;
}
__device__ __forceinline__ int lane_fresh() { int l; asm volatile("v_mbcnt_lo_u32_b32 %0, -1, 0\n\tv_mbcnt_hi_u32_b32 %0, -1, %0" : "=v"(l)); return l; }
__device__ __forceinline__ void swap_halves(float& a, float& b) {
    const auto r = __builtin_amdgcn_permlane32_swap(__builtin_bit_cast(unsigned, a), __builtin_bit_cast(unsigned, b), false, false);
    unsigned x = r[0], y = r[1];
    asm volatile("" : "+v"(x), "+v"(y));
    a = __builtin_bit_cast(float, x); b = __builtin_bit_cast(float, y);
}
__device__ __forceinline__ float sum4(f32x4 v) { return (v[0] + v[1]) + (v[2] + v[3]); }
__device__ __forceinline__ float fq_sum(float v) { v += __shfl_xor(v, 16); v += __shfl_xor(v, 32); return v; }
__device__ __forceinline__ float silu_f(float v) { return v * __builtin_amdgcn_rcpf(1.0f + __builtin_amdgcn_exp2f(-v * LOG2E)); }
__device__ __forceinline__ f32x2 gelu_pk(f32x2 v) {
    f32x2 vc; vc.x = __builtin_amdgcn_fmed3f(v.x, -4.5f, 4.5f); vc.y = __builtin_amdgcn_fmed3f(v.y, -4.5f, 4.5f);
    const f32x2 t = vc * vc;
    f32x2 q = t * (-1.400032542e-12f) + 1.697268853e-10f;
    q = q * t + (-9.193600548e-09f); q = q * t + 2.958863661e-07f; q = q * t + (-6.365206445e-06f); q = q * t + 9.787092858e-05f;
    q = q * t + (-1.122676185e-03f); q = q * t + 9.833178483e-03f; q = q * t + (-6.633704901e-02f); q = q * t + 3.988837898e-01f;
    const f32x2 ph = vc * q + 0.5f;
    return v * ph;
}
__device__ __forceinline__ f32x4 gelu4(f32x4 v) { f32x2 a = gelu_pk((f32x2){v[0], v[1]}), b = gelu_pk((f32x2){v[2], v[3]}); return (f32x4){a.x, a.y, b.x, b.y}; }
__device__ __forceinline__ f32x4 silu4(f32x4 v) { return (f32x4){silu_f(v[0]), silu_f(v[1]), silu_f(v[2]), silu_f(v[3])}; }
__device__ __forceinline__ u32x4 pack8(f32x4 a, f32x4 b) { u32x4 w; w.x = pk2(a[0], a[1]); w.y = pk2(a[2], a[3]); w.z = pk2(b[0], b[1]); w.w = pk2(b[2], b[3]); return w; }

namespace pg8 {
constexpr int BM = 256, BK = 64, HALF = 128, HTB = HALF * BK * 2, STAGE_BYTES = 8 * HTB, NXCD = 8, WGM = 4;
__device__ __forceinline__ int lds_byte(int r, int c) { const int st = (r >> 4) * 2 + (c >> 5), rr = r & 15, cc = c & 31, ob = rr * 64 + cc * 2; return st * 1024 + (ob ^ (((ob >> 9) & 1) << 5)); }
__device__ __forceinline__ void stage_rc(int b, int& R, int& C) { const int st = b / 1024, sb = b % 1024, swz = sb ^ (((sb >> 9) & 1) << 5); R = (st >> 1) * 16 + swz / 64; C = (st & 1) * 32 + (swz % 64) / 2; }
__device__ __forceinline__ int perm32(int rho) { const int n = rho >> 4, i = rho & 15; return 8 * (i >> 2) + 4 * n + (i & 3); }
struct Unit { int pm, pn; };
struct Gemm { const bf16_t* A; const bf16_t* Bt; int M, N, K; };
struct StaticOrder {
    int nM, nN, nwg, G, c;
    __device__ void init(int M, int N, int G_, int c_) { nM = M / BM; nN = N / BM; nwg = nM * nN; G = G_; c = c_; }
    __device__ bool next(int i, Unit& u) const {
        const long L = (long)i * G + c; if (L >= nwg) return false;
        int wgid = (int)L; { const int q = nwg / NXCD, r = nwg % NXCD, xcd = wgid % NXCD, off = wgid / NXCD; wgid = (xcd < r ? xcd * (q + 1) : r * (q + 1) + (xcd - r) * q) + off; }
        const int nig = WGM * nN, gid = wgid / nig, fm = gid * WGM, gsz = (nM - fm) < WGM ? (nM - fm) : WGM;
        u.pm = fm + ((wgid % nig) % gsz); u.pn = (wgid % nig) / gsz; return true;
    }
};

template <class Epi, class Sched>
__device__ __forceinline__ void gemm_phase(LAS unsigned char* lds, const Gemm g, const Sched& S, const Epi& E, const int wid) {
    const int lane = lane_fresh(), tid = wid * 64 + lane, wr = wid >> 2, wc = wid & 3, fr = lane & 15, fq = lane >> 4;
    const int K = g.K, nt = K / BK;
    unsigned voffA[2], voffB[2];
#pragma unroll
    for (int i = 0; i < 2; ++i) { int R, C; stage_rc(tid * 16 + i * 8192, R, C); const int Rb = 2 * (R & ~31) + perm32(R & 31);
        voffA[i] = (unsigned)(R * K + C) * 2u; voffB[i] = (unsigned)(Rb * K + C) * 2u; }
    const size_t kstep = (size_t)(BK * 2);
    const size_t hstep = (size_t)HALF * K * 2;
    const size_t tstep = 2 * hstep;
    const size_t bstep = (size_t)32 * K * 2;
    const unsigned ldsw = (unsigned)wid * 1024u;
    const int aoff = lds_byte(wr * 64 + fr, fq * 8), boff = lds_byte(wc * 32 + fr, fq * 8);
#define PG8_SA(b, h) (((b) * 2 + (h)) * HTB)
#define PG8_SB(b, h) ((4 + (b) * 2 + (h)) * HTB)
#define PG8_STAGE(bufoff, gbase, voff) do { _Pragma("unroll") for (int _i = 0; _i < 2; ++_i) \
        __builtin_amdgcn_global_load_lds((const unsigned*)((const char*)(gbase) + (voff)[_i]), (LAS unsigned*)(lds + (bufoff) + ldsw + _i * 8192), 16, 0, 0); } while (0)
#define PG8_LDA(dst, b, h) do { _Pragma("unroll") for (int m = 0; m < 4; ++m) _Pragma("unroll") for (int k = 0; k < 2; ++k) dst[m][k] = *(const LAS bf16x8*)(lds + PG8_SA(b, h) + aoff + m * 2048 + k * 1024); } while (0)
#define PG8_LDB(dst, b, h) do { _Pragma("unroll") for (int n = 0; n < 2; ++n) _Pragma("unroll") for (int k = 0; k < 2; ++k) dst[n][k] = *(const LAS bf16x8*)(lds + PG8_SB(b, h) + boff + n * 2048 + k * 1024); } while (0)
#define PG8_MMA(ai, bj, At, Bt) do { __builtin_amdgcn_s_setprio(1); _Pragma("unroll") for (int m = 0; m < 4; ++m) _Pragma("unroll") for (int n = 0; n < 2; ++n) _Pragma("unroll") for (int k = 0; k < 2; ++k) \
        acc[ai][bj][m][n] = __builtin_amdgcn_mfma_f32_16x16x32_bf16(Bt[n][k], At[m][k], acc[ai][bj][m][n], 0, 0, 0); __builtin_amdgcn_s_setprio(0); } while (0)
#define PG8_WAIT_V(n) asm volatile("s_waitcnt vmcnt(" #n ")" ::: "memory")
#define PG8_WAIT_L(n) asm volatile("s_waitcnt lgkmcnt(" #n ")" ::: "memory")
#define PG8_BAR __builtin_amdgcn_s_barrier()
#define PG8_SCHED __builtin_amdgcn_sched_barrier(0)
    Unit cur, nxt; int ui = 0;
    if (!S.next(0, cur)) return;
    f32x4 acc[2][2][4][2];
    if constexpr (Epi::INIT) E.init(acc, cur, 0, wr, wc, fr, fq);
    else {
#pragma unroll
    for (int a = 0; a < 2; ++a)
#pragma unroll
        for (int b = 0; b < 2; ++b)
#pragma unroll
            for (int m = 0; m < 4; ++m)
#pragma unroll
                for (int n = 0; n < 2; ++n) acc[a][b][m][n] = (f32x4){0.f, 0.f, 0.f, 0.f};
    }
    bf16x8 At[4][2], B0[2][2], B1[2][2];
    const char* cA = (const char*)g.A + (size_t)cur.pm * tstep; const char* cB = (const char*)g.Bt + (size_t)cur.pn * tstep;
    PG8_STAGE(PG8_SB(0, 0), cB, voffB); PG8_STAGE(PG8_SB(0, 1), cB + bstep, voffB); PG8_STAGE(PG8_SA(0, 0), cA, voffA); PG8_STAGE(PG8_SA(0, 1), cA + hstep, voffA);
    if (wr == 1) PG8_BAR;
    PG8_WAIT_V(2); PG8_BAR;
    PG8_STAGE(PG8_SB(1, 0), cB + kstep, voffB); PG8_STAGE(PG8_SA(1, 0), cA + kstep, voffA); PG8_STAGE(PG8_SB(1, 1), cB + bstep + kstep, voffB);
    PG8_WAIT_V(6); PG8_BAR;
    for (;;) {
        const bool has_next = S.next(ui + 1, nxt);
        const char* nA = has_next ? (const char*)g.A + (size_t)nxt.pm * tstep : cA; const char* nB = has_next ? (const char*)g.Bt + (size_t)nxt.pn * tstep : cB;
        for (int t = 0; t < nt; t += 2) {
            const bool last = (t == nt - 2);
            const char* a1 = cA + (size_t)(t + 1) * kstep;
            const char* a2 = last ? nA : cA + (size_t)(t + 2) * kstep; const char* b2 = last ? nB : cB + (size_t)(t + 2) * kstep;
            const char* a3 = a2 + kstep; const char* b3 = b2 + kstep;
            if constexpr (Epi::MID) { if (t == nt / 2) E.mid(acc, cur, ui, wr, wc, fr, fq); }
            PG8_LDB(B0, 0, 0); PG8_LDB(B1, 0, 1); PG8_SCHED; PG8_LDA(At, 0, 0); PG8_STAGE(PG8_SA(1, 1), a1 + hstep, voffA);
            PG8_WAIT_V(8); PG8_WAIT_L(0); PG8_BAR; PG8_MMA(0, 0, At, B0); PG8_MMA(0, 1, At, B1); PG8_BAR; PG8_SCHED;
            PG8_LDA(At, 0, 1); PG8_STAGE(PG8_SB(0, 0), b2, voffB); PG8_STAGE(PG8_SB(0, 1), b2 + bstep, voffB); PG8_STAGE(PG8_SA(0, 0), a2, voffA);
            PG8_WAIT_V(8); PG8_WAIT_L(0); PG8_BAR; PG8_MMA(1, 0, At, B0); PG8_MMA(1, 1, At, B1); PG8_BAR; PG8_SCHED;
            PG8_LDB(B0, 1, 0); PG8_LDB(B1, 1, 1); PG8_SCHED; PG8_LDA(At, 1, 0); PG8_STAGE(PG8_SA(0, 1), a2 + hstep, voffA);
            PG8_WAIT_V(8); PG8_WAIT_L(0); PG8_BAR; PG8_MMA(0, 0, At, B0); PG8_MMA(0, 1, At, B1); PG8_BAR; PG8_SCHED;
            PG8_LDA(At, 1, 1); PG8_STAGE(PG8_SB(1, 0), b3, voffB); PG8_STAGE(PG8_SB(1, 1), b3 + bstep, voffB); PG8_STAGE(PG8_SA(1, 0), a3, voffA);
            PG8_WAIT_V(8); PG8_WAIT_L(0); PG8_BAR; PG8_MMA(1, 0, At, B0); PG8_MMA(1, 1, At, B1); PG8_BAR; PG8_SCHED;
        }
        if (wr == 0) PG8_BAR;
        E(acc, cur, ui, wr, wc, fr, fq);
        if (!has_next) break;
        if constexpr (Epi::INIT) E.init(acc, nxt, ui + 1, wr, wc, fr, fq);
        else {
#pragma unroll
        for (int a = 0; a < 2; ++a)
#pragma unroll
            for (int b = 0; b < 2; ++b)
#pragma unroll
                for (int m = 0; m < 4; ++m)
#pragma unroll
                    for (int n = 0; n < 2; ++n) acc[a][b][m][n] = (f32x4){0.f, 0.f, 0.f, 0.f};
        }
        cur = nxt; cA = nA; cB = nB; ++ui;
        if (wr == 1) PG8_BAR;
    }
    PG8_WAIT_V(0);
    PG8_BAR;
#undef PG8_SA
#undef PG8_SB
#undef PG8_STAGE
#undef PG8_LDA
#undef PG8_LDB
#undef PG8_MMA
#undef PG8_WAIT_V
#undef PG8_WAIT_L
#undef PG8_BAR
#undef PG8_SCHED
}
}

struct EpiIn {
    static constexpr bool MID = false, INIT = false;
    bf16_t* P; const LAS float* rows; float* svg; float* knp; float* nvp; float* nks; float* nvs; LAS unsigned char* stg;
    template <int KIND>
    __device__ __forceinline__ void body(const f32x4 (&acc)[2][2][4][2], const pg8::Unit& u, int ui, int wr, int wc, int fr, int fq) const {
        const int row0 = u.pm * 256 + wr * 64 + fr;
        const int col0 = u.pn * 256 + wc * 64 + 8 * fq;
        const LAS float* rsl = rows + ui * 256 + wr * 64 + fr;
        const int sl = fq * 16 + fr, srow = sl >> 3, spc = sl & 7;
        LAS unsigned char* sw = stg ? stg + (wr * 4 + wc) * 2304 : nullptr;
#pragma unroll
        for (int ai = 0; ai < 2; ++ai)
#pragma unroll
            for (int m = 0; m < 4; ++m) {
                const int row = row0 + ai * 128 + m * 16;
                const float rs = rsl[ai * 128 + m * 16];
                bf16_t* rowp = P + (size_t)row * DPROJ + col0;
                float* dst = nullptr;
                if (KIND == 4) {
                    float* bp = (u.pn == 5) ? nvp : knp; float* bs = (u.pn == 5) ? nvs : nks;
                    if (u.pm < 128) { if ((u.pm & 7) == 7 && ai == 1) dst = bp + (size_t)((u.pm >> 3) * 128 + wr * 64 + m * 16 + fr) * 256 + wc * 64 + 8 * fq; }
                    else { const int sr = row - NP; dst = bs + (size_t)((sr >> 5) * 128 + 96 + (sr & 31)) * 256 + wc * 64 + 8 * fq; }
                }
                float s1 = 0.f, s2 = 0.f;
#pragma unroll
                for (int bj = 0; bj < 2; ++bj) {
                    f32x4 v0 = acc[ai][bj][m][0] * rs, v1 = acc[ai][bj][m][1] * rs;
                    if (KIND == 1) { v0 = silu4(v0); v1 = silu4(v1); }
                    if (KIND == 2 || KIND == 3) { v0 = gelu4(v0); v1 = gelu4(v1); }
                    if (KIND == 3) { s1 += (v0[0] + v0[1]) + (v0[2] + v0[3]) + (v1[0] + v1[1]) + (v1[2] + v1[3]);
                        s2 += (v0[0] * v0[0] + v0[1] * v0[1]) + (v0[2] * v0[2] + v0[3] * v0[3]) + (v1[0] * v1[0] + v1[1] * v1[1]) + (v1[2] * v1[2] + v1[3] * v1[3]); }
                    if (sw) *(LAS u32x4*)(sw + fr * 144 + bj * 64 + fq * 16) = pack8(v0, v1);
                    else *(u32x4*)(rowp + bj * 32) = pack8(v0, v1);
                    if (KIND == 4) { if (dst) { *(f32x4*)(dst + bj * 32) = v0; *(f32x4*)(dst + bj * 32 + 4) = v1; } }
                }
                if (sw) {
                    bf16_t* gb = P + (size_t)(u.pm * 256 + ai * 128 + wr * 64 + m * 16 + srow) * DPROJ + u.pn * 256 + wc * 64 + spc * 8;
                    const u32x4 w0 = *(const LAS u32x4*)(sw + srow * 144 + spc * 16), w1 = *(const LAS u32x4*)(sw + (srow + 8) * 144 + spc * 16);
                    *(u32x4*)gb = w0; *(u32x4*)(gb + (size_t)8 * DPROJ) = w1;
                }
                if (KIND == 3) {
                    s1 = fq_sum(s1); s2 = fq_sum(s2);
                    if (fq == 0) *(f32x2*)(svg + ((size_t)row * 16 + (u.pn - 14) * 4 + wc) * 2) = (f32x2){s1, s2};
                }
            }
    }
    __device__ __forceinline__ void operator()(const f32x4 (&acc)[2][2][4][2], const pg8::Unit& u, int ui, int wr, int wc, int fr, int fq) const {
        const int pn = u.pn;
        if (pn < 4) body<0>(acc, u, ui, wr, wc, fr, fq);
        else if (pn < 6) body<4>(acc, u, ui, wr, wc, fr, fq);
        else if (pn < 10 || pn >= 18) body<1>(acc, u, ui, wr, wc, fr, fq);
        else if (pn < 14) body<2>(acc, u, ui, wr, wc, fr, fq);
        else body<3>(acc, u, ui, wr, wc, fr, fq);
    }
};

struct EpiOut {
    static constexpr bool MID = true, INIT = true;
    float* out; bf16_t* xb; float* ssx; const LAS float* rows; int last;
    __device__ __forceinline__ void init(f32x4 (&acc)[2][2][4][2], const pg8::Unit& u, int ui, int wr, int wc, int fr, int fq) const {
        int row0 = u.pm * 256 + wr * 64 + fr;
        asm volatile("" : "+v"(row0));
        const int col0 = u.pn * 256 + wc * 64 + 8 * fq;
        const LAS float* rl = rows + ui * 768 + ((row0 - u.pm * 256));
#pragma unroll
        for (int ai = 0; ai < 2; ++ai)
#pragma unroll
            for (int m = 0; m < 4; ++m) {
                const int row = row0 + ai * 128 + m * 16;
                const bf16_t* base = xb + (size_t)row * DM + col0;
#pragma unroll
                for (int bj = 0; bj < 2; ++bj) { const u32x4 w = *(const u32x4*)(base + bj * 32);
                    acc[ai][bj][m][0] = (f32x4){bf_lo(w.x), bf_hi(w.x), bf_lo(w.y), bf_hi(w.y)}; acc[ai][bj][m][1] = (f32x4){bf_lo(w.z), bf_hi(w.z), bf_lo(w.w), bf_hi(w.w)}; }
            }
#pragma unroll
        for (int ai = 0; ai < 2; ++ai)
#pragma unroll
            for (int m = 0; m < 4; ++m) {
                const float ia = rl[ai * 128 + m * 16];
#pragma unroll
                for (int bj = 0; bj < 2; ++bj)
#pragma unroll
                    for (int n = 0; n < 2; ++n) acc[ai][bj][m][n] = acc[ai][bj][m][n] * ia;
            }
    }
    __device__ __forceinline__ void mid(f32x4 (&acc)[2][2][4][2], const pg8::Unit& u, int ui, int wr, int wc, int fr, int fq) const {
        int rt = wr * 64 + fr;
        asm volatile("" : "+v"(rt));
        const LAS float* rl = rows + ui * 768 + 256 + rt;
#pragma unroll
        for (int ai = 0; ai < 2; ++ai)
#pragma unroll
            for (int m = 0; m < 4; ++m) {
                const float ratio = rl[ai * 128 + m * 16];
#pragma unroll
                for (int bj = 0; bj < 2; ++bj)
#pragma unroll
                    for (int n = 0; n < 2; ++n) acc[ai][bj][m][n] = acc[ai][bj][m][n] * ratio;
            }
    }
    __device__ __forceinline__ void operator()(const f32x4 (&acc)[2][2][4][2], const pg8::Unit& u, int ui, int wr, int wc, int fr, int fq) const {
        const int row0 = u.pm * 256 + wr * 64 + fr;
        const int col0 = u.pn * 256 + wc * 64 + 8 * fq;
        const LAS float* rl = rows + ui * 768 + 512 + wr * 64 + fr;
#pragma unroll
        for (int ai = 0; ai < 2; ++ai)
#pragma unroll
            for (int m = 0; m < 4; ++m) {
                const int row = row0 + ai * 128 + m * 16;
                const float rb = rl[ai * 128 + m * 16];
                float* o = out + (size_t)row * DM + col0; bf16_t* xo = xb + (size_t)row * DM + col0;
                float ss = 0.f;
#pragma unroll
                for (int bj = 0; bj < 2; ++bj) {
                    const f32x4 v0 = acc[ai][bj][m][0] * rb, v1 = acc[ai][bj][m][1] * rb;
                    if (last) { *(f32x4*)(o + bj * 32) = v0; *(f32x4*)(o + bj * 32 + 4) = v1; }
                    else *(u32x4*)(xo + bj * 32) = pack8(v0, v1);
                    ss += (v0[0] * v0[0] + v0[1] * v0[1]) + (v0[2] * v0[2] + v0[3] * v0[3]) + (v1[0] * v1[0] + v1[1] * v1[1]) + (v1[2] * v1[2] + v1[3] * v1[3]);
                }
                ss = fq_sum(ss);
                if (fq == 0) ssx[(size_t)row * 32 + u.pn * 4 + wc] = ss;
                asm volatile("" ::: "memory");
            }
    }
};

struct TItem { const float* W; const float* gk; bf16_t* WT; int N, k0, n0; };
__device__ __forceinline__ TItem p0_item(const Params& p, bf16_t* WIN, bf16_t* WOUT, int it) {
    constexpr int I_IN = (DM / 64) * (DPROJ / 32), I_OUT = (DM / 64) * (DM / 32), I_L = I_IN + I_OUT;
    const int l = it / I_L; int r = it - l * I_L; TItem t;
    if (r < I_IN) { const int nblk = DPROJ / 32, kb = r / nblk; t.k0 = 64 * kb; t.n0 = 32 * (r - kb * nblk); t.N = DPROJ; t.W = p.w_in + (size_t)l * DM * DPROJ; t.gk = p.norm_in + l * DM + t.k0; t.WT = WIN + (size_t)l * DPROJ * DM; }
    else { r -= I_IN; const int nblk = DM / 32, kb = r / nblk; t.k0 = 64 * kb; t.n0 = 32 * (r - kb * nblk); t.N = DM; t.W = p.w_out + (size_t)l * DM * DM;
        t.gk = (t.k0 < 1024) ? p.norm_attn + l * 1024 + t.k0 : p.norm_gmlp + l * 1024 + (t.k0 - 1024); t.WT = WOUT + (size_t)l * DM * DM; }
    return t;
}
__device__ __forceinline__ void p0_load(const TItem& t, f32x4 (&v)[8], int lane) {
#pragma unroll
    for (int i = 0; i < 8; ++i) { const int kk = 8 * i + (lane >> 3); v[i] = *(const f32x4*)(t.W + (size_t)(t.k0 + kk) * t.N + t.n0 + 4 * (lane & 7)) * t.gk[kk]; }
}
__device__ __forceinline__ void p0_emit(const TItem& t, const f32x4 (&v)[8], LAS float* scr, int lane) {
#pragma unroll
    for (int i = 0; i < 8; ++i) { LAS float* d = scr + (8 * i + (lane >> 3)) * 33 + 4 * (lane & 7); d[0] = v[i][0]; d[1] = v[i][1]; d[2] = v[i][2]; d[3] = v[i][3]; }
    asm volatile("s_waitcnt lgkmcnt(0)" ::: "memory");
    const int c = lane & 7;
#pragma unroll
    for (int j = 0; j < 4; ++j) { const int n = (lane >> 3) + 8 * j; const LAS float* sp = scr + (8 * c) * 33 + n;
        u32x4 o; o.x = pk2(sp[0 * 33], sp[1 * 33]); o.y = pk2(sp[2 * 33], sp[3 * 33]); o.z = pk2(sp[4 * 33], sp[5 * 33]); o.w = pk2(sp[6 * 33], sp[7 * 33]);
        *(u32x4*)(t.WT + (size_t)(t.n0 + n) * DM + t.k0 + 8 * c) = o; }
    asm volatile("s_waitcnt lgkmcnt(0)" ::: "memory");
}

__device__ __forceinline__ void prologue(LAS unsigned char* lds, const Params& p, int tid, int wave, int lane, int bid, int G) {
    lane = lane_fresh(); tid = wave * 64 + lane;
    unsigned char* ws = p.ws;
    bf16_t* WIN = (bf16_t*)(ws + WS_WIN); bf16_t* WOUT = (bf16_t*)(ws + WS_WOUT); bf16_t* XB = (bf16_t*)(ws + WS_XB);
    float* SSX = (float*)(ws + WS_SSX);
    LAS float* scr = (LAS float*)(lds + wave * 17408);
    const int gw = bid * 8 + wave, NGW = G * 8;
    constexpr int NIT = DEPTH * ((DM / 64) * (DPROJ / 32) + (DM / 64) * (DM / 32));
    for (int it = gw; it < NIT; it += 2 * NGW) {
        const bool two = it + NGW < NIT;
        const TItem ta = p0_item(p, WIN, WOUT, it), tb = p0_item(p, WIN, WOUT, two ? it + NGW : it);
        f32x4 va[8], vb[8];
        p0_load(ta, va, lane); if (two) p0_load(tb, vb, lane);
        p0_emit(ta, va, scr, lane); if (two) p0_emit(tb, vb, scr + 64 * 33, lane);
    }
    for (int row = gw; row < MT; row += 2 * NGW) {
        const int row2 = row + NGW; const bool two = row2 < MT; const int rb = two ? row2 : row;
        const f32x4* xa = (const f32x4*)(row < NP ? p.x_prompt + (size_t)row * DM : p.x_sample + (size_t)(row - NP) * DM) + lane;
        const f32x4* xb2 = (const f32x4*)(rb < NP ? p.x_prompt + (size_t)rb * DM : p.x_sample + (size_t)(rb - NP) * DM) + lane;
        f32x4 va[8], vb[8];
#pragma unroll
        for (int j = 0; j < 8; ++j) va[j] = xa[64 * j];
#pragma unroll
        for (int j = 0; j < 8; ++j) vb[j] = xb2[64 * j];
        u32x2* oa = (u32x2*)(XB + (size_t)row * DM) + lane; u32x2* ob = (u32x2*)(XB + (size_t)rb * DM) + lane;
        float sa = 0.f, sb = 0.f;
#pragma unroll
        for (int j = 0; j < 8; ++j) { const f32x4 v = va[j]; sa += (v[0] * v[0] + v[1] * v[1]) + (v[2] * v[2] + v[3] * v[3]); u32x2 w; w.x = pk2(v[0], v[1]); w.y = pk2(v[2], v[3]); oa[64 * j] = w; }
        if (two) {
#pragma unroll
            for (int j = 0; j < 8; ++j) { const f32x4 v = vb[j]; sb += (v[0] * v[0] + v[1] * v[1]) + (v[2] * v[2] + v[3] * v[3]); u32x2 w; w.x = pk2(v[0], v[1]); w.y = pk2(v[2], v[3]); ob[64 * j] = w; }
        }
        sa = wave_sum(sa); sb = wave_sum(sb);
        if (lane < 32) { SSX[(size_t)row * 32 + lane] = (lane == 0) ? sa : 0.f; if (two) SSX[(size_t)row2 * 32 + lane] = (lane == 0) ? sb : 0.f; }
    }
    for (int seg = bid; seg < 256; seg += G) {
        const int kv = seg >> 7, lb = seg & 127;
        const f32x4* src = (const f32x4*)((kv ? p.cache_v : p.cache_k) + ((size_t)lb * 128 + 32) * 256);
        f32x4* dst = (f32x4*)(p.out + (kv ? OUT_NVS : OUT_NKS) + (size_t)lb * 128 * 256);
        for (int i = tid; i < 96 * 64; i += 512) dst[i] = src[i];
    }
}

constexpr int L_KS = 0, L_VT = 27648, L_WS = 73728, L_MUR = 108544, L_BIAS = 131072;
#define MFMA32(a, b, c) __builtin_amdgcn_mfma_f32_32x32x16_bf16((a), (b), (c), 0, 0, 0)
__device__ __forceinline__ bf16x8 pack_step(const f32x16& x, int s) {
    u32x4 w; w.x = pk2(x[8 * s], x[8 * s + 1]); w.y = pk2(x[8 * s + 2], x[8 * s + 3]); w.z = pk2(x[8 * s + 4], x[8 * s + 5]); w.w = pk2(x[8 * s + 6], x[8 * s + 7]);
    return __builtin_bit_cast(bf16x8, w);
}

__device__ __forceinline__ void attn_task(LAS unsigned char* lds, const Params& p, const bf16_t* P, bf16_t* Y, float* ssa, int l, bool sample, int b, int c, int kvh, int tid, int wave, int lane) {
    lane = lane_fresh(); tid = wave * 64 + lane;
    LAS bf16_t* KS = (LAS bf16_t*)(lds + L_KS);
    LAS bf16_t* VT = (LAS bf16_t*)(lds + L_VT);
    const LAS float* BIAS = (const LAS float*)(lds + L_BIAS);
    const int nk = sample ? 160 : 192;
    const int jmin = sample ? 0 : (c >= 2 ? 0 : (2 - c) * 64);
    for (int id = tid; id < nk * 8; id += 512) {
        const int j = id >> 3, ch = id & 7;
        if (j >= jmin) {
            u32x4 w;
            if (sample && j < 128) { const float* src = p.cache_k + ((((size_t)l * 32 + b) * 128 + j) * 4 + kvh) * 64 + ch * 8; w = pack8(*(const f32x4*)src, *(const f32x4*)(src + 4)); }
            else { const size_t row = sample ? (size_t)NP + b * 32 + (j - 128) : (size_t)b * 2048 + (c - 2) * 64 + j; w = *(const u32x4*)(P + row * DPROJ + O_K + kvh * 64 + ch * 8); }
            *(LAS u32x4*)(KS + j * 72 + ch * 8) = w;
        }
    }
    for (int id = tid; id < nk * 8; id += 512) {
        const int ch = id / nk, j = id - ch * nk;
        if (j >= jmin) {
            u32x4 w;
            if (sample && j < 128) { const float* src = p.cache_v + ((((size_t)l * 32 + b) * 128 + j) * 4 + kvh) * 64 + ch * 8; w = pack8(*(const f32x4*)src, *(const f32x4*)(src + 4)); }
            else { const size_t row = sample ? (size_t)NP + b * 32 + (j - 128) : (size_t)b * 2048 + (c - 2) * 64 + j; w = *(const u32x4*)(P + row * DPROJ + O_V + kvh * 64 + ch * 8); }
#pragma unroll
            for (int e = 0; e < 4; ++e) { VT[(ch * 8 + 2 * e) * 200 + j] = (bf16_t)(w[e] & 0xffffu); VT[(ch * 8 + 2 * e + 1) * 200 + j] = (bf16_t)(w[e] >> 16); }
        }
    }
    __syncthreads();
    const int r = lane & 31, h = lane >> 5;
    const bool active = sample ? (wave < 4) : true;
    if (active) {
        const int g = sample ? wave : (wave >> 1), qh = sample ? 0 : (wave & 1);
        const int head = kvh * 4 + g, i = 32 * qh + r;
        const size_t qrow = sample ? (size_t)NP + b * 32 + i : (size_t)b * 2048 + c * 64 + i;
        bf16x8 qf[4];
#pragma unroll
        for (int s = 0; s < 4; ++s) qf[s] = *(const bf16x8*)(P + qrow * DPROJ + O_Q + head * 64 + 16 * s + 8 * h);
        const bf16_t* gp = P + qrow * DPROJ + O_GA + head * 64 + 8 * h;
        u32x4 gwv[4];
#pragma unroll
        for (int e = 0; e < 4; ++e) gwv[e] = *(const u32x4*)(gp + 16 * e);
        const int T0 = jmin >> 5, NT = nk >> 5;
        f32x16 st[6];
#pragma unroll
        for (int T = 0; T < 6; ++T) {
            f32x16 acc;
            if (T >= T0 && T < NT) {
#pragma unroll
                for (int e = 0; e < 16; ++e) acc[e] = 0.f;
#pragma unroll
                for (int s = 0; s < 4; ++s) { const bf16x8 a = *(const LAS bf16x8*)(KS + (32 * T + r) * 72 + 16 * s + 8 * h); acc = MFMA32(a, qf[s], acc); }
            } else {
#pragma unroll
                for (int e = 0; e < 16; ++e) acc[e] = -1e30f;
            }
            st[T] = acc;
        }
        const float sc = 0.125f * LOG2E;
        const LAS float* bl = BIAS + head * 256 + 63 - i + 4 * h;
        float mx = -3e38f;
#pragma unroll
        for (int T = 0; T < 6; ++T)
            if (T >= T0 && T < NT) {
#pragma unroll
                for (int e = 0; e < 16; ++e) { const float v = st[T][e] * sc + bl[32 * T + (e & 3) + 8 * (e >> 2)]; st[T][e] = v; mx = fmaxf(mx, v); }
                }
        mx = fmaxf(mx, __shfl_xor(mx, 32));
        const float sink2 = p.sinks[l * 16 + head] * LOG2E;
        mx = fmaxf(mx, sink2);
        float sum = 0.f;
#pragma unroll
        for (int T = 0; T < 6; ++T)
#pragma unroll
            for (int e = 0; e < 16; ++e) { const float pv = __builtin_amdgcn_exp2f(st[T][e] - mx); st[T][e] = pv; sum += pv; }
        sum += __shfl_xor(sum, 32);
        sum += __builtin_amdgcn_exp2f(sink2 - mx);
        const float inv = 1.0f / sum;
        f32x16 o[2];
#pragma unroll
        for (int e = 0; e < 16; ++e) { o[0][e] = 0.f; o[1][e] = 0.f; }
#pragma unroll
        for (int T = 0; T < 6; ++T)
            if (T >= T0 && T < NT) {
#pragma unroll
                for (int s = 0; s < 2; ++s) {
                    const bf16x8 xs = pack_step(st[T], s);
#pragma unroll
                    for (int dt = 0; dt < 2; ++dt) {
                        const LAS bf16_t* vp = VT + (32 * dt + r) * 200 + 32 * T + 16 * s + 4 * h;
                        const s16x4 lo = *(const LAS s16x4*)vp, hi = *(const LAS s16x4*)(vp + 8);
                        const bf16x8 pa = __builtin_shufflevector(lo, hi, 0, 1, 2, 3, 4, 5, 6, 7);
                        o[dt] = MFMA32(pa, xs, o[dt]);
                    }
                }
                }
        float ss = 0.f;
        bf16_t* yp = Y + qrow * DM + head * 64 + 8 * h;
#pragma unroll
        for (int dt = 0; dt < 2; ++dt)
#pragma unroll
            for (int pr = 0; pr < 2; ++pr) {
                float a[4], bq[4];
#pragma unroll
                for (int k = 0; k < 4; ++k) { a[k] = o[dt][8 * pr + k] * inv; bq[k] = o[dt][8 * pr + 4 + k] * inv; }
                ss += ((a[0] * a[0] + a[1] * a[1]) + (a[2] * a[2] + a[3] * a[3])) + ((bq[0] * bq[0] + bq[1] * bq[1]) + (bq[2] * bq[2] + bq[3] * bq[3]));
#pragma unroll
                for (int k = 0; k < 4; ++k) swap_halves(a[k], bq[k]);
                const u32x4 gw = gwv[2 * dt + pr];
                u32x4 w; w.x = pk2(a[0] * bf_lo(gw.x), a[1] * bf_hi(gw.x)); w.y = pk2(a[2] * bf_lo(gw.y), a[3] * bf_hi(gw.y));
                w.z = pk2(bq[0] * bf_lo(gw.z), bq[1] * bf_hi(gw.z)); w.w = pk2(bq[2] * bf_lo(gw.w), bq[3] * bf_hi(gw.w));
                *(u32x4*)(yp + 32 * dt + 16 * pr) = w;
            }
        ss += __shfl_xor(ss, 32);
        if (h == 0) ssa[qrow * 16 + head] = ss;
    }
    __syncthreads();
}

__device__ __forceinline__ void attn_run(LAS unsigned char* lds, const Params& p, const bf16_t* P, bf16_t* Y, float* ssa, int l, int t0, int t1, int wave) {
    if (t0 >= t1) return;
    const int lane = lane_fresh(), tid = wave * 64 + lane;
    LAS bf16_t* KS = (LAS bf16_t*)(lds + L_KS);
    LAS bf16_t* VT = (LAS bf16_t*)(lds + L_VT);
    const LAS float* BIAS = (const LAS float*)(lds + L_BIAS);
    const int r = lane & 31, h = lane >> 5;
    const int jk = tid >> 3, chk = tid & 7;
    const int jv = jk, chv = chk;
    u32x4 pk = (u32x4){0u, 0u, 0u, 0u}, pv = pk;
    bf16x8 qn[4];
#pragma unroll
    for (int s = 0; s < 4; ++s) qn[s] = (bf16x8){0, 0, 0, 0, 0, 0, 0, 0};
    int prev_bk = -1, prev_c = -100;
    for (int t = t0; t < t1; ++t) {
        const int c = t & 31, bk = t >> 5, kvh = bk & 3, b = bk >> 2;
        const bool cont = (bk == prev_bk) && (c == prev_c + 1);
        const bf16_t* Pk = P + ((size_t)b * 2048 + jk) * DPROJ + O_K + kvh * 64 + chk * 8;
        const bf16_t* Pv = P + ((size_t)b * 2048 + jv) * DPROJ + O_V + kvh * 64 + chv * 8;
        if (cont) {
            const int slot = c % 3;
            *(LAS u32x4*)(KS + (slot * 64 + jk) * 72 + chk * 8) = pk;
            *(LAS u32x4*)(VT + (slot * 64 + jv) * 72 + chv * 8) = pv;
        } else {
            for (int q = (c >= 2 ? c - 2 : 0); q <= c; ++q) {
                const int slot = q % 3;
                const u32x4 wk = *(const u32x4*)(Pk + (size_t)q * 64 * DPROJ), wv = *(const u32x4*)(Pv + (size_t)q * 64 * DPROJ);
                *(LAS u32x4*)(KS + (slot * 64 + jk) * 72 + chk * 8) = wk;
                *(LAS u32x4*)(VT + (slot * 64 + jv) * 72 + chv * 8) = wv;
            }
        }
        __syncthreads();
        {
            const int g = wave >> 1, qh = wave & 1;
            const int head = kvh * 4 + g, i = 32 * qh + r;
            const size_t qrow = (size_t)b * 2048 + c * 64 + i;
            const bf16_t* qp = P + qrow * DPROJ + O_Q + head * 64 + 8 * h;
            bf16x8 qf[4];
            if (cont) {
#pragma unroll
                for (int s = 0; s < 4; ++s) qf[s] = qn[s];
            } else {
#pragma unroll
                for (int s = 0; s < 4; ++s) qf[s] = *(const bf16x8*)(qp + 16 * s);
            }
            if (t + 1 < t1 && ((t + 1) >> 5) == bk) {
                pk = *(const u32x4*)(Pk + (size_t)(c + 1) * 64 * DPROJ); pv = *(const u32x4*)(Pv + (size_t)(c + 1) * 64 * DPROJ);
#pragma unroll
                for (int s = 0; s < 4; ++s) qn[s] = *(const bf16x8*)(qp + (size_t)64 * DPROJ + 16 * s);
            }
            const bf16_t* gp = P + qrow * DPROJ + O_GA + head * 64 + 8 * h;
            u32x4 gwv[4];
#pragma unroll
            for (int e = 0; e < 4; ++e) gwv[e] = *(const u32x4*)(gp + 16 * e);
            const int T0 = c >= 2 ? 0 : 2 * (2 - c);
            const int sl0 = (c + 1) % 3, sl1 = (c + 2) % 3, sl2 = c % 3;
            f32x16 st[6];
#pragma unroll
            for (int T = 0; T < 6; ++T) {
                f32x16 acc;
                const int prow = 64 * ((T >> 1) == 0 ? sl0 : ((T >> 1) == 1 ? sl1 : sl2)) + 32 * (T & 1);
                if (T >= T0) {
#pragma unroll
                    for (int e = 0; e < 16; ++e) acc[e] = 0.f;
#pragma unroll
                    for (int s = 0; s < 4; ++s) { const bf16x8 a = *(const LAS bf16x8*)(KS + (prow + r) * 72 + 16 * s + 8 * h); acc = MFMA32(a, qf[s], acc); }
                } else {
#pragma unroll
                    for (int e = 0; e < 16; ++e) acc[e] = -1e30f;
                }
                st[T] = acc;
            }
            const float sc = 0.125f * LOG2E;
            const LAS float* bl = BIAS + head * 256 + 63 - i + 4 * h;
            float mx = -3e38f;
#pragma unroll
            for (int T = 0; T < 6; ++T)
                if (T >= T0) {
#pragma unroll
                    for (int e = 0; e < 16; ++e) { const float v = st[T][e] * sc + bl[32 * T + (e & 3) + 8 * (e >> 2)]; st[T][e] = v; mx = fmaxf(mx, v); }
                }
            mx = fmaxf(mx, __shfl_xor(mx, 32));
            const float sink2 = p.sinks[l * 16 + head] * LOG2E;
            mx = fmaxf(mx, sink2);
            float sum = 0.f;
#pragma unroll
            for (int T = 0; T < 6; ++T)
#pragma unroll
                for (int e = 0; e < 16; ++e) { const float pe = __builtin_amdgcn_exp2f(st[T][e] - mx); st[T][e] = pe; sum += pe; }
            sum += __shfl_xor(sum, 32);
            sum += __builtin_amdgcn_exp2f(sink2 - mx);
            const float inv = 1.0f / sum;
            f32x16 o[2];
#pragma unroll
            for (int e = 0; e < 16; ++e) { o[0][e] = 0.f; o[1][e] = 0.f; }
#pragma unroll
            for (int T = 0; T < 6; ++T)
                if (T >= T0) {
                    const int prow = 64 * ((T >> 1) == 0 ? sl0 : ((T >> 1) == 1 ? sl1 : sl2)) + 32 * (T & 1);
#pragma unroll
                    for (int s = 0; s < 2; ++s) {
                        const bf16x8 xs = pack_step(st[T], s);
#pragma unroll
                        for (int dt = 0; dt < 2; ++dt) {
                            const LAS bf16_t* vp = VT + (prow + 16 * s + 4 * h + ((lane & 15) >> 2)) * 72 + 32 * dt + 16 * ((lane >> 4) & 1) + 4 * (lane & 3);
                            const s16x4 lo = __builtin_amdgcn_ds_read_tr16_b64_v4i16((LAS s16x4*)vp), hi = __builtin_amdgcn_ds_read_tr16_b64_v4i16((LAS s16x4*)(vp + 8 * 72));
                            const bf16x8 pa = __builtin_shufflevector(lo, hi, 0, 1, 2, 3, 4, 5, 6, 7);
                            o[dt] = MFMA32(pa, xs, o[dt]);
                        }
                    }
                }
            float ss = 0.f;
            bf16_t* yp = Y + qrow * DM + head * 64 + 8 * h;
#pragma unroll
            for (int dt = 0; dt < 2; ++dt)
#pragma unroll
                for (int pr = 0; pr < 2; ++pr) {
                    float a[4], bq[4];
#pragma unroll
                    for (int k = 0; k < 4; ++k) { a[k] = o[dt][8 * pr + k] * inv; bq[k] = o[dt][8 * pr + 4 + k] * inv; }
                    ss += ((a[0] * a[0] + a[1] * a[1]) + (a[2] * a[2] + a[3] * a[3])) + ((bq[0] * bq[0] + bq[1] * bq[1]) + (bq[2] * bq[2] + bq[3] * bq[3]));
#pragma unroll
                    for (int k = 0; k < 4; ++k) swap_halves(a[k], bq[k]);
                    const u32x4 gw = gwv[2 * dt + pr];
                    u32x4 w; w.x = pk2(a[0] * bf_lo(gw.x), a[1] * bf_hi(gw.x)); w.y = pk2(a[2] * bf_lo(gw.y), a[3] * bf_hi(gw.y));
                    w.z = pk2(bq[0] * bf_lo(gw.z), bq[1] * bf_hi(gw.z)); w.w = pk2(bq[2] * bf_lo(gw.w), bq[3] * bf_hi(gw.w));
                    *(u32x4*)(yp + 32 * dt + 16 * pr) = w;
                }
            ss += __shfl_xor(ss, 32);
            if (h == 0) ssa[qrow * 16 + head] = ss;
        }
        __syncthreads();
        prev_bk = bk; prev_c = c;
    }
}

__device__ __forceinline__ int vgt_off(int sidx) { return sidx * 18432; }
__device__ __forceinline__ void gmlp_task(LAS unsigned char* lds, const Params& p, const bf16_t* P, bf16_t* Y, const float* svg, float* ssb, int l, bool sample, int b, int g, int q, int tid, int wave, int lane, bool load_ws = true) {
    lane = lane_fresh(); tid = wave * 64 + lane;
    LAS bf16_t* WSL = (LAS bf16_t*)(lds + L_WS);
    LAS f32x2* MUR = (LAS f32x2*)(lds + L_MUR);
    if (load_ws) {
        const float* wsp = p.w_spatial + (size_t)(l * 16 + g) * 128 * 128;
#pragma unroll
        for (int k = 0; k < 4; ++k) {
            const int id = tid + 512 * k, i = id >> 4, j0 = (id & 15) * 8;
            f32x4 a = *(const f32x4*)(wsp + i * 128 + j0), bb = *(const f32x4*)(wsp + i * 128 + j0 + 4);
#pragma unroll
            for (int e = 0; e < 4; ++e) { if (j0 + e > i) a[e] = 0.f; if (j0 + 4 + e > i) bb[e] = 0.f; }
            *(LAS u32x4*)(WSL + i * 136 + j0) = pack8(a, bb);
        }
    }
    const int L = sample ? 32 : 128;
    const int r = lane & 31, h = lane >> 5;
    const float* lg = p.ln_v_g + l * 1024 + g * 64; const float* lb = p.ln_v_b + l * 1024 + g * 64;
    u32x4 wraw[4][2];
#pragma unroll
    for (int sub = 0; sub < 4; ++sub) {
        const int cidx = q * 4 + sub;
        const size_t row0 = sample ? (size_t)NP + cidx * 32 : (size_t)b * 2048 + cidx * 128;
#pragma unroll
        for (int k = 0; k < 2; ++k) {
            const int id = tid + 512 * k;
            if (id < L * 8) { const int ch = id & 7, j = id >> 3; wraw[sub][k] = *(const u32x4*)(P + (row0 + j) * DPROJ + O_VG + g * 64 + ch * 8); }
            else wraw[sub][k] = (u32x4){0u, 0u, 0u, 0u};
        }
    }
#pragma unroll
    for (int sub = 0; sub < 4; ++sub) {
        const int cidx = q * 4 + sub;
        const size_t row0 = sample ? (size_t)NP + cidx * 32 : (size_t)b * 2048 + cidx * 128;
        if ((tid >> 2) < L) {
            const int j = tid >> 2, qq = tid & 3;
            const f32x4* sp = (const f32x4*)(svg + ((row0 + j) * 16 + qq * 4) * 2);
            const f32x4 a = sp[0], bq = sp[1];
            float s1 = (a[0] + a[2]) + (bq[0] + bq[2]), s2 = (a[1] + a[3]) + (bq[1] + bq[3]);
            s1 += __shfl_xor(s1, 1); s1 += __shfl_xor(s1, 2); s2 += __shfl_xor(s2, 1); s2 += __shfl_xor(s2, 2);
            const float mean = s1 * (1.0f / 1024.0f), var = s2 * (1.0f / 1024.0f) - mean * mean;
            if (qq == 0) MUR[sub * 128 + j] = (f32x2){mean, __builtin_amdgcn_rsqf(var + EPS)};
        }
    }
    __syncthreads();
#pragma unroll
    for (int sub = 0; sub < 4; ++sub) {
        const int cidx = q * 4 + sub;
        const size_t row0 = sample ? (size_t)NP + cidx * 32 : (size_t)b * 2048 + cidx * 128;
        LAS bf16_t* VGT = (LAS bf16_t*)(lds + vgt_off(sub));
#pragma unroll
        for (int k = 0; k < 2; ++k) {
            const int id = tid + 512 * k;
            if (id >= L * 8) continue;
            const int ch = id & 7, j = id >> 3;
            const f32x2 mr = MUR[sub * 128 + j];
            const float mean = mr.x, rstd = mr.y;
            const u32x4 w = wraw[sub][k];
            const f32x4 g0 = *(const f32x4*)(lg + ch * 8), g1 = *(const f32x4*)(lg + ch * 8 + 4), b0 = *(const f32x4*)(lb + ch * 8), b1 = *(const f32x4*)(lb + ch * 8 + 4);
            f32x4 v0 = (f32x4){bf_lo(w.x), bf_hi(w.x), bf_lo(w.y), bf_hi(w.y)}, v1 = (f32x4){bf_lo(w.z), bf_hi(w.z), bf_lo(w.w), bf_hi(w.w)};
            v0 = (v0 - mean) * rstd * g0 + b0; v1 = (v1 - mean) * rstd * g1 + b1;
            if (sample) { float* dst = p.out + OUT_VGS + ((((size_t)l * 32 + cidx) * 32 + j) * 16 + g) * 64 + ch * 8; *(f32x4*)dst = v0; *(f32x4*)(dst + 4) = v1; }
            *(LAS u32x4*)(VGT + j * 72 + ch * 8) = pack8(v0, v1);
        }
    }
    __syncthreads();
    const int it = sample ? 0 : (wave >> 1), dt = wave & 1;
    const bool active = sample ? (wave < 2) : true;
    if (active) {
        const int i = 32 * it + r;
        const float bias = p.b_spatial[(l * 16 + g) * 128 + i];
        const int nks = 2 * (it + 1);
#pragma unroll
        for (int sub = 0; sub < 4; ++sub) {
            const int cidx = q * 4 + sub;
            const size_t row0 = sample ? (size_t)NP + cidx * 32 : (size_t)b * 2048 + cidx * 128;
            const LAS bf16_t* VGT = (const LAS bf16_t*)(lds + vgt_off(sub));
            const size_t row = row0 + i;
            const bf16_t* up = P + row * DPROJ + O_U + g * 64 + 32 * dt + 8 * h;
            const bf16_t* gp = P + row * DPROJ + O_GB + g * 64 + 32 * dt + 8 * h;
            u32x4 uw[2], gw[2];
#pragma unroll
            for (int pr = 0; pr < 2; ++pr) { uw[pr] = *(const u32x4*)(up + 16 * pr); gw[pr] = *(const u32x4*)(gp + 16 * pr); }
            f32x16 acc;
#pragma unroll
            for (int e = 0; e < 16; ++e) acc[e] = 0.f;
            const LAS bf16_t* tr = VGT + (8 * h + ((lane & 15) >> 2)) * 72 + 32 * dt + 16 * ((lane >> 4) & 1) + 4 * (lane & 3);
            for (int ks = 0; ks < nks; ++ks) {
                const s16x4 alo = __builtin_amdgcn_ds_read_tr16_b64_v4i16((LAS s16x4*)(tr + 16 * ks * 72)), ahi = __builtin_amdgcn_ds_read_tr16_b64_v4i16((LAS s16x4*)(tr + (16 * ks + 4) * 72));
                const bf16x8 a = __builtin_shufflevector(alo, ahi, 0, 1, 2, 3, 4, 5, 6, 7);
                const bf16x8 bw = *(const LAS bf16x8*)(WSL + (32 * it + r) * 136 + 16 * ks + 8 * h);
                acc = MFMA32(a, bw, acc);
            }
            bf16_t* yp = Y + row * DM + 1024 + g * 64 + 32 * dt + 8 * h;
            float ss = 0.f;
#pragma unroll
            for (int pr = 0; pr < 2; ++pr) {
                float a[4], bq[4];
#pragma unroll
                for (int k = 0; k < 4; ++k) { a[k] = acc[8 * pr + k] + bias; bq[k] = acc[8 * pr + 4 + k] + bias; }
#pragma unroll
                for (int k = 0; k < 4; ++k) swap_halves(a[k], bq[k]);
                const u32x4 u4 = uw[pr], g4 = gw[pr];
                a[0] *= bf_lo(u4.x); a[1] *= bf_hi(u4.x); a[2] *= bf_lo(u4.y); a[3] *= bf_hi(u4.y); bq[0] *= bf_lo(u4.z); bq[1] *= bf_hi(u4.z); bq[2] *= bf_lo(u4.w); bq[3] *= bf_hi(u4.w);
                ss += ((a[0] * a[0] + a[1] * a[1]) + (a[2] * a[2] + a[3] * a[3])) + ((bq[0] * bq[0] + bq[1] * bq[1]) + (bq[2] * bq[2] + bq[3] * bq[3]));
                u32x4 w; w.x = pk2(a[0] * bf_lo(g4.x), a[1] * bf_hi(g4.x)); w.y = pk2(a[2] * bf_lo(g4.y), a[3] * bf_hi(g4.y));
                w.z = pk2(bq[0] * bf_lo(g4.z), bq[1] * bf_hi(g4.z)); w.w = pk2(bq[2] * bf_lo(g4.w), bq[3] * bf_hi(g4.w));
                *(u32x4*)(yp + 16 * pr) = w;
            }
            ss += __shfl_xor(ss, 32);
            if (h == 0) ssb[row * 32 + g * 2 + dt] = ss;
        }
    }
    __syncthreads();
}

#define XB_TMO      128
#define XB_XCNT(j)  (256  + 64 * (j))
#define XB_XSUB(j)  (1280 + 64 * (j))
#define XB_XGEN(j)  (2304 + 64 * (j))
#define XB_TOP      3328
#define XB_TOPGEN   3392
#define XCD_BAR_WORDS 3456
#define XB_SPIN_CAP (1u << 18)

__device__ __forceinline__ unsigned xb_ld(unsigned* p)              { return __hip_atomic_load(p, __ATOMIC_RELAXED, __HIP_MEMORY_SCOPE_AGENT); }
__device__ __forceinline__ unsigned xb_add(unsigned* p, unsigned v) { return __hip_atomic_fetch_add(p, v, __ATOMIC_RELAXED, __HIP_MEMORY_SCOPE_AGENT); }
__device__ __forceinline__ unsigned xb_xcc_id() { return (unsigned)__builtin_amdgcn_s_getreg((3 << 11) | 20) & 0xFu; }
#define XB_SPIN(cond, bar) do { unsigned _sp = 0; while (cond) { __builtin_amdgcn_s_sleep(1); \
    if ((++_sp & 255u) == 0u) { if (xb_ld(&(bar)[XB_TMO])) break; if (_sp > XB_SPIN_CAP) { atomicAdd(&(bar)[XB_TMO], 1u); break; } } } } while (0)

struct XcdBarrier {
    unsigned* bar; unsigned x;
    volatile LAS unsigned* st;
};

__device__ __forceinline__ XcdBarrier xcd_barrier_post(unsigned* bar, volatile LAS unsigned* st) {
    XcdBarrier b; b.bar = bar; b.x = xb_xcc_id(); b.st = st;
    if (threadIdx.x == 0) (void)xb_add(&bar[XB_XCNT(b.x)], 1u);
    return b;
}
__device__ __forceinline__ void xcd_barrier_complete(unsigned* bar, unsigned x, unsigned& nloc, unsigned& nx) {
    const unsigned G = gridDim.x * gridDim.y * gridDim.z;
    unsigned sum, cnt, mine, sp = 0u;
    for (;;) {
        sum = 0u; cnt = 0u; mine = 0u;
#pragma unroll
        for (unsigned j = 0; j < 16; ++j) { const unsigned c = xb_ld(&bar[XB_XCNT(j)]); sum += c; cnt += (c > 0u) ? 1u : 0u; mine = (j == x) ? c : mine; }
        if (sum == G) break;
        __builtin_amdgcn_s_sleep(1);
        if ((++sp & 255u) == 0u) { if (xb_ld(&bar[XB_TMO])) break; if (sp > XB_SPIN_CAP) { atomicAdd(&bar[XB_TMO], 1u); break; } }
    }
    nloc = mine > 0u ? mine : 1u; nx = cnt > 0u ? cnt : 1u;
}

__device__ __forceinline__ void xcd_barrier(const XcdBarrier& b) {
    asm volatile("s_waitcnt vmcnt(0)" ::: "memory");
    __syncthreads();
    if (threadIdx.x == 0) {
        unsigned* bar = b.bar;
        __builtin_amdgcn_s_waitcnt(0);
        unsigned nloc = b.st[0], nx = b.st[1];
        if (nloc == 0u) { xcd_barrier_complete(bar, b.x, nloc, nx); b.st[0] = nloc; b.st[1] = nx; }
        const unsigned old = xb_add(&bar[XB_XSUB(b.x)], 1u);
        const unsigned gen = old / nloc;
        if (old + 1u == (gen + 1u) * nloc) {
            __builtin_amdgcn_fence(__ATOMIC_RELEASE, "agent");
            asm volatile("s_waitcnt vmcnt(0)" ::: "memory");
            const unsigned og = xb_add(&bar[XB_TOP], 1u);
            const unsigned tg = og / nx;
            if (og + 1u == (tg + 1u) * nx) xb_add(&bar[XB_TOPGEN], 1u);
            else XB_SPIN(xb_ld(&bar[XB_TOPGEN]) == tg, bar);
            __builtin_amdgcn_fence(__ATOMIC_ACQUIRE, "agent");
            xb_add(&bar[XB_XGEN(b.x)], 1u);
            asm volatile("s_waitcnt vmcnt(0)" ::: "memory");
        } else {
            XB_SPIN(xb_ld(&bar[XB_XGEN(b.x)]) == gen, bar);
            __builtin_amdgcn_fence(__ATOMIC_ACQUIRE, "agent");
            asm volatile("s_waitcnt vmcnt(0)" ::: "memory");
        }
    }
    __syncthreads();
}


struct OneUnit { int pm, pn; __device__ bool next(int i, pg8::Unit& u) const { if (i != 0) return false; u.pm = pm; u.pn = pn; return true; } };

template <class Sched>
__device__ __forceinline__ void run_in_proj(LAS unsigned char* lds, const Params& p, int l, const Sched& S, int M, int rows_off, int wave, int stage_off = -1) {
    unsigned char* ws = p.ws;
    const float* SSX = (const float*)(ws + WS_SSX);
    {
        const int ln = lane_fresh(), t = wave * 64 + ln, r = t >> 1, hf = t & 1;
        LAS float* rows = (LAS float*)(lds + rows_off); pg8::Unit u;
        for (int i = 0; i < 12 && S.next(i, u); ++i) {
            const f32x4* sp = (const f32x4*)(SSX + ((size_t)u.pm * 256 + r) * 32 + hf * 16);
            float sm = (sum4(sp[0]) + sum4(sp[1])) + (sum4(sp[2]) + sum4(sp[3]));
            sm += __shfl_xor(sm, 1);
            if (hf == 0) rows[i * 256 + r] = __builtin_amdgcn_rsqf(sm * (1.0f / 2048.0f) + EPS);
        }
        __syncthreads();
    }
    pg8::Gemm g{(const bf16_t*)(ws + WS_XB), (const bf16_t*)(ws + WS_WIN) + (size_t)l * DPROJ * DM, M, DPROJ, DM};
    EpiIn E{(bf16_t*)(ws + WS_P), (const LAS float*)(lds + rows_off), (float*)(ws + WS_SVG), p.out + OUT_KNP + (size_t)l * 524288, p.out + OUT_NVP + (size_t)l * 524288, p.out + OUT_NKS + (size_t)l * 1048576, p.out + OUT_NVS + (size_t)l * 1048576,
            stage_off >= 0 ? lds + stage_off : (LAS unsigned char*)nullptr};
    pg8::gemm_phase<EpiIn, Sched>(lds, g, S, E, wave);
}
template <class Sched>
__device__ __forceinline__ void run_out_proj(LAS unsigned char* lds, const Params& p, int l, const Sched& S, int M, int rows_off, int wave) {
    unsigned char* ws = p.ws;
    const float* SSA = (const float*)(ws + WS_SSA); const float* SSB = (const float*)(ws + WS_SSB);
    {
        const int ln = lane_fresh(), t = wave * 64 + ln, r = t >> 1, hf = t & 1;
        LAS float* rows = (LAS float*)(lds + rows_off); pg8::Unit u;
        for (int i = 0; i < 10 && S.next(i, u); ++i) {
            const size_t row = (size_t)u.pm * 256 + r;
            const f32x4* ap = (const f32x4*)(SSA + row * 16 + hf * 8); const f32x4* bp = (const f32x4*)(SSB + row * 32 + hf * 16);
            float sa = sum4(ap[0]) + sum4(ap[1]), sb = (sum4(bp[0]) + sum4(bp[1])) + (sum4(bp[2]) + sum4(bp[3]));
            sa += __shfl_xor(sa, 1); sb += __shfl_xor(sb, 1);
            const float a = sa * (1.0f / 1024.0f) + EPS, b = sb * (1.0f / 1024.0f) + EPS;
            if (hf == 0) { rows[i * 768 + r] = __builtin_sqrtf(a); rows[i * 768 + 256 + r] = __builtin_amdgcn_rsqf(a) * __builtin_sqrtf(b); rows[i * 768 + 512 + r] = __builtin_amdgcn_rsqf(b); }
        }
        __syncthreads();
    }
    pg8::Gemm g{(const bf16_t*)(ws + WS_Y), (const bf16_t*)(ws + WS_WOUT) + (size_t)l * DM * DM, M, DM, DM};
    EpiOut E{p.out, (bf16_t*)(ws + WS_XB), (float*)(ws + WS_SSX), (const LAS float*)(lds + rows_off), 0};
    pg8::gemm_phase<EpiOut, Sched>(lds, g, S, E, wave);
}

__device__ __forceinline__ void block_arrive(unsigned* cnt) {
    asm volatile("s_waitcnt vmcnt(0)" ::: "memory");
    __syncthreads();
    if (threadIdx.x == 0) { __builtin_amdgcn_fence(__ATOMIC_RELEASE, "agent"); asm volatile("s_waitcnt vmcnt(0)" ::: "memory"); (void)__hip_atomic_fetch_add(cnt, 1u, __ATOMIC_RELAXED, __HIP_MEMORY_SCOPE_AGENT); }
}
__device__ __forceinline__ void block_wait(unsigned* cnt, unsigned want) {
    if (threadIdx.x == 0) {
        unsigned spins = 0;
        while (__hip_atomic_load(cnt, __ATOMIC_RELAXED, __HIP_MEMORY_SCOPE_AGENT) < want) { __builtin_amdgcn_s_sleep(4); if (++spins > (1u << 24)) break; }
        __builtin_amdgcn_fence(__ATOMIC_ACQUIRE, "agent"); asm volatile("s_waitcnt vmcnt(0)" ::: "memory");
    }
    __syncthreads();
}

__device__ __forceinline__ void p2_phase(LAS unsigned char* lds, const Params& p, int l, int tid, int wave, int lane, int bid, int G) {
    lane = lane_fresh(); tid = wave * 64 + lane;
    unsigned char* ws = p.ws;
    const bf16_t* P = (const bf16_t*)(ws + WS_P); bf16_t* Y = (bf16_t*)(ws + WS_Y);
    const float* SVG = (const float*)(ws + WS_SVG); float* SSA = (float*)(ws + WS_SSA); float* SSB = (float*)(ws + WS_SSB);
    unsigned* CNT = (unsigned*)(ws + WS_CNT) + l * 512;
    LAS float* BIAS = (LAS float*)(lds + L_BIAS);
    for (int id = tid; id < 16 * 256; id += 512) {
        const int hh = id >> 8, idx = id & 255, rel = idx - 191, n = rel < 0 ? -rel : rel;
        int bk = n; if (n >= 8) { bk = 33 - __builtin_clz((unsigned)(n * n)); if (bk > 15) bk = 15; }
        bk += (rel > 0) ? 16 : 0;
        BIAS[id] = p.rel_bias[bk * 16 + hh] * LOG2E;
    }
    __syncthreads();
    if (bid < 128) attn_task(lds, p, P, Y, SSA, l, true, bid >> 2, 0, bid & 3, tid, wave, lane);
    else { const int u = bid - 128; gmlp_task(lds, p, P, Y, SVG, SSB, l, true, 0, u >> 3, u & 7, tid, wave, lane); }
    block_arrive(CNT);
    const int ngemm = (l < DEPTH - 1) ? 120 : 32;
    int start, count;
    if (bid < ngemm) { start = bid * 10; count = 10; }
    else { const int rest = 3072 - ngemm * 10, nb = 256 - ngemm, q = rest / nb, rem = rest - q * nb, j = bid - ngemm; start = ngemm * 10 + j * q + (j < rem ? j : rem); count = q + (j < rem ? 1 : 0); }
    const int end = start + count;
    const int ta0 = 2 * (start / 3) + (start % 3 < 2 ? start % 3 : 2), ta1 = 2 * (end / 3) + (end % 3 < 2 ? end % 3 : 2), ug0 = start / 3, ug1 = end / 3;
    const int tsplit = (bid < 32) ? (ta0 + 2 < ta1 ? ta0 + 2 : ta1) : ta1;
    attn_run(lds, p, P, Y, SSA, l, ta0, tsplit, wave);
    if (bid < 32) {
        block_wait(CNT, 256u);
        OneUnit S{128 + (bid >> 3), bid & 7};
        run_out_proj<OneUnit>(lds, p, l, S, MT, L_ROWS + 16384, wave);
        block_arrive(CNT + 64 * (1 + (bid >> 3)));
    }
    attn_run(lds, p, P, Y, SSA, l, tsplit, ta1, wave);
    for (int u = ug0; u < ug1; ++u)
        gmlp_task(lds, p, P, Y, SVG, SSB, l, false, (u >> 2) & 15, u >> 6, u & 3, tid, wave, lane, u == ug0 || (u >> 6) != ((u - 1) >> 6));
    if (bid >= 32 && bid < ngemm) {
        const int idx = bid - 32, tile = idx / 22;
        block_wait(CNT + 64 * (1 + tile), 8u);
        OneUnit S{128 + tile, idx - tile * 22};
        run_in_proj<OneUnit>(lds, p, l + 1, S, MT, L_ROWS + 16384, wave);
    }
}

__global__ void __launch_bounds__(512, 2) fwd_megakernel(Params p) {
    extern __shared__ __attribute__((aligned(16))) unsigned char lds_raw[];
    LAS unsigned char* lds = (LAS unsigned char*)lds_raw;
    cg::grid_group grid = cg::this_grid();
    const int wave = __builtin_amdgcn_readfirstlane(threadIdx.x >> 6), tid = 0, lane = 0, G = gridDim.x, bid = blockIdx.x;
    unsigned char* ws = p.ws;
    float* SSX = (float*)(ws + WS_SSX);

    {
        volatile LAS unsigned* st = (volatile LAS unsigned*)(lds + LDS_BYTES - 64);
        if (threadIdx.x < 2) st[threadIdx.x] = 0u;
        __syncthreads();
    }
    const XcdBarrier xbar = xcd_barrier_post((unsigned*)(ws + WS_CNT) + 4096, (volatile LAS unsigned*)(lds + LDS_BYTES - 64));
    prologue(lds, p, tid, wave, lane, bid, G);
    grid.sync();
#pragma unroll 1
    for (int l = 0; l < DEPTH; ++l) {
        {
            const int M = (l == 0) ? MT : NP;
            pg8::StaticOrder S; S.init(M, DPROJ, G, bid);
            run_in_proj<pg8::StaticOrder>(lds, p, l, S, M, L_ROWS, wave, L_ROWS + 12288);
        }
        xcd_barrier(xbar);
        p2_phase(lds, p, l, tid, wave, lane, bid, G);
        xcd_barrier(xbar);
        {
            pg8::StaticOrder S; S.init(NP, DM, G, bid);
            run_out_proj<pg8::StaticOrder>(lds, p, l, S, NP, L_ROWS, wave);
        }
        xcd_barrier(xbar);
    }
    {
        const int ll = lane_fresh();
        const int gw = bid * 8 + wave, NGW = G * 8;
        const f32x4* gf = (const f32x4*)p.norm_final + ll;
        const bf16_t* XBf = (const bf16_t*)(ws + WS_XB);
        f32x4 gv[8];
#pragma unroll
        for (int j = 0; j < 8; ++j) gv[j] = gf[64 * j];
        for (int row = gw; row < MT; row += 2 * NGW) {
            const int row2 = row + NGW; const bool two = row2 < MT; const int rb = two ? row2 : row;
            const u32x2* xa = (const u32x2*)(XBf + (size_t)row * DM) + ll; const u32x2* xb2 = (const u32x2*)(XBf + (size_t)rb * DM) + ll;
            u32x2 wa[8], wb[8];
#pragma unroll
            for (int j = 0; j < 8; ++j) wa[j] = xa[64 * j];
#pragma unroll
            for (int j = 0; j < 8; ++j) wb[j] = xb2[64 * j];
            const float pa = ll < 32 ? SSX[(size_t)row * 32 + ll] : 0.f, pb = ll < 32 ? SSX[(size_t)rb * 32 + ll] : 0.f;
            const float ra = __builtin_amdgcn_rsqf(wave_sum(pa) * (1.0f / 2048.0f) + EPS), rbs = __builtin_amdgcn_rsqf(wave_sum(pb) * (1.0f / 2048.0f) + EPS);
            f32x4* oa = (f32x4*)(p.out + (size_t)row * DM) + ll; f32x4* ob = (f32x4*)(p.out + (size_t)rb * DM) + ll;
#pragma unroll
            for (int j = 0; j < 8; ++j) { const u32x2 w = wa[j]; oa[64 * j] = (f32x4){bf_lo(w.x), bf_hi(w.x), bf_lo(w.y), bf_hi(w.y)} * ra * gv[j]; }
            if (two) {
#pragma unroll
                for (int j = 0; j < 8; ++j) { const u32x2 w = wb[j]; ob[64 * j] = (f32x4){bf_lo(w.x), bf_hi(w.x), bf_lo(w.y), bf_hi(w.y)} * rbs * gv[j]; }
            }
        }
    }
}

extern "C" void kernel_launch(void* const* d_in, const int* in_sizes, int n_in, void* d_out, int out_size, void* d_ws, size_t ws_size, hipStream_t stream) {
    static int grid = 0;
    if (grid == 0) {
        if (n_in != 16 || ws_size < WS_END) { fprintf(stderr, "kernel_launch: unexpected n_in %d / ws_size %zu\n", n_in, ws_size); grid = -1; return; }
        int dev = 0, cus = 0, per_cu = 0;
        hipGetDevice(&dev);
        hipDeviceGetAttribute(&cus, hipDeviceAttributeMultiprocessorCount, dev);
        hipFuncSetAttribute((const void*)fwd_megakernel, hipFuncAttributeMaxDynamicSharedMemorySize, LDS_BYTES);
        hipOccupancyMaxActiveBlocksPerMultiprocessor(&per_cu, (const void*)fwd_megakernel, 512, LDS_BYTES);
        if (per_cu < 1) per_cu = 1;
        (void)hipGetLastError();
        grid = cus * per_cu;
        if (grid != 256) { fprintf(stderr, "kernel_launch: this kernel's phase-2 schedule is built for a 256-workgroup grid, got %d\n", grid); grid = -1; return; }
    }
    if (grid < 0) return;
    Params p{};
    p.x_prompt = (const float*)d_in[0]; p.x_sample = (const float*)d_in[1]; p.cache_k = (const float*)d_in[2]; p.cache_v = (const float*)d_in[3];
    p.w_in = (const float*)d_in[4]; p.w_out = (const float*)d_in[5]; p.norm_in = (const float*)d_in[6]; p.rel_bias = (const float*)d_in[7]; p.sinks = (const float*)d_in[8];
    p.norm_attn = (const float*)d_in[9]; p.norm_gmlp = (const float*)d_in[10]; p.ln_v_g = (const float*)d_in[11]; p.ln_v_b = (const float*)d_in[12];
    p.w_spatial = (const float*)d_in[13]; p.b_spatial = (const float*)d_in[14]; p.norm_final = (const float*)d_in[15];
    p.out = (float*)d_out; p.ws = (unsigned char*)d_ws;
    (void)hipMemsetAsync((unsigned char*)d_ws + WS_CNT, 0, 65536, stream);
    void* args[] = {&p};
    hipError_t e = hipLaunchCooperativeKernel((const void*)fwd_megakernel, dim3(grid), dim3(512), args, LDS_BYTES, stream);
    if (e != hipSuccess) fprintf(stderr, "cooperative launch failed: %s (grid %d)\n", hipGetErrorString(e), grid);
}
```

```cpp
#include <hip/hip_runtime.h>
#include <hip/hip_cooperative_groups.h>
#include <cstdio>
#include <cstdint>
namespace cg = cooperative_groups;

#define LAS __attribute__((address_space(3)))
typedef unsigned short bf16_t;
typedef short bf16x8 __attribute__((ext_vector_type(8)));
typedef short s16x4 __attribute__((ext_vector_type(4)));
typedef float f32x4 __attribute__((ext_vector_type(4)));
typedef float f32x2 __attribute__((ext_vector_type(2)));
typedef float f32x16 __attribute__((ext_vector_type(16)));
typedef unsigned u32x4 __attribute__((ext_vector_type(4)));
typedef unsigned u32x2 __attribute__((ext_vector_type(2)));

constexpr int DM = 2048, NP = 16 * 2048, NS = 32 * 32, MT = NP + NS, DPROJ = 5632, DEPTH = 4;
constexpr int O_Q = 0, O_K = 1024, O_V = 1280, O_GA = 1536, O_U = 2560, O_VG = 3584, O_GB = 4608;
constexpr float EPS = 1e-6f, LOG2E = 1.4426950408889634f;
constexpr size_t OUT_KNP = (size_t)MT * DM, OUT_NVP = OUT_KNP + 2097152, OUT_NKS = OUT_NVP + 2097152, OUT_NVS = OUT_NKS + 4194304, OUT_VGS = OUT_NVS + 4194304;
constexpr size_t MiB = 1u << 20;
constexpr size_t WS_WIN = 0, WS_WOUT = 88 * MiB, WS_XB = 120 * MiB, WS_P = 252 * MiB, WS_Y = 616 * MiB, WS_SSX = 748 * MiB, WS_SVG = 753 * MiB, WS_SSA = 758 * MiB, WS_SSB = 761 * MiB, WS_CNT = 766 * MiB, WS_END = 767 * MiB;
static_assert((size_t)DEPTH * DPROJ * DM * 2 <= WS_WOUT && WS_WOUT + (size_t)DEPTH * DM * DM * 2 <= WS_XB && WS_XB + (size_t)MT * DM * 2 <= WS_P && WS_P + (size_t)MT * DPROJ * 2 <= WS_Y && WS_Y + (size_t)MT * DM * 2 <= WS_SSX, "ws map");
constexpr int LDS_BYTES = 163840, L_ROWS = 131072;

struct Params {
    const float *x_prompt, *x_sample, *cache_k, *cache_v, *w_in, *w_out, *norm_in, *rel_bias, *sinks, *norm_attn, *norm_gmlp, *ln_v_g, *ln_v_b, *w_spatial, *b_spatial, *norm_final;
    float* out; unsigned char* ws;
};

__device__ __forceinline__ unsigned f2bf(float f) { unsigned u = __builtin_bit_cast(unsigned, f); return (u + 0x7fffu + ((u >> 16) & 1u)) >> 16; }
typedef __bf16 bf16x2_t __attribute__((ext_vector_type(2)));
__device__ __forceinline__ unsigned pk2(float lo, float hi) { const f32x2 v = {lo, hi}; return __builtin_bit_cast(unsigned, __builtin_convertvector(v, bf16x2_t)); }
__device__ __forceinline__ float bf_lo(unsigned w) { return __builtin_bit_cast(float, w << 16); }
__device__ __forceinline__ float bf_hi(unsigned w) { return __builtin_bit_cast(float, w & 0xffff0000u); }
__device__ __forceinline__ float wave_sum(float v) {
#pragma unroll
    for (int o = 1; o < 64; o <<= 1) v += __shfl_xor(v, o);
    return v;
}
__device__ __forceinline__ int lane_fresh() { int l; asm volatile("v_mbcnt_lo_u32_b32 %0, -1, 0\n\tv_mbcnt_hi_u32_b32 %0, -1, %0" : "=v"(l)); return l; }
__device__ __forceinline__ void swap_halves(float& a, float& b) {
    const auto r = __builtin_amdgcn_permlane32_swap(__builtin_bit_cast(unsigned, a), __builtin_bit_cast(unsigned, b), false, false);
    unsigned x = r[0], y = r[1];
    asm volatile("" : "+v"(x), "+v"(y));
    a = __builtin_bit_cast(float, x); b = __builtin_bit_cast(float, y);
}
__device__ __forceinline__ float sum4(f32x4 v) { return (v[0] + v[1]) + (v[2] + v[3]); }
__device__ __forceinline__ float fq_sum(float v) { v += __shfl_xor(v, 16); v += __shfl_xor(v, 32); return v; }
__device__ __forceinline__ float silu_f(float v) { return v * __builtin_amdgcn_rcpf(1.0f + __builtin_amdgcn_exp2f(-v * LOG2E)); }
__device__ __forceinline__ f32x2 gelu_pk(f32x2 v) {
    f32x2 vc; vc.x = __builtin_amdgcn_fmed3f(v.x, -4.5f, 4.5f); vc.y = __builtin_amdgcn_fmed3f(v.y, -4.5f, 4.5f);
    const f32x2 t = vc * vc;
    f32x2 q = t * (-1.400032542e-12f) + 1.697268853e-10f;
    q = q * t + (-9.193600548e-09f); q = q * t + 2.958863661e-07f; q = q * t + (-6.365206445e-06f); q = q * t + 9.787092858e-05f;
    q = q * t + (-1.122676185e-03f); q = q * t + 9.833178483e-03f; q = q * t + (-6.633704901e-02f); q = q * t + 3.988837898e-01f;
    const f32x2 ph = vc * q + 0.5f;
    return v * ph;
}
__device__ __forceinline__ f32x4 gelu4(f32x4 v) { f32x2 a = gelu_pk((f32x2){v[0], v[1]}), b = gelu_pk((f32x2){v[2], v[3]}); return (f32x4){a.x, a.y, b.x, b.y}; }
__device__ __forceinline__ f32x4 silu4(f32x4 v) { return (f32x4){silu_f(v[0]), silu_f(v[1]), silu_f(v[2]), silu_f(v[3])}; }
__device__ __forceinline__ u32x4 pack8(f32x4 a, f32x4 b) { u32x4 w; w.x = pk2(a[0], a[1]); w.y = pk2(a[2], a[3]); w.z = pk2(b[0], b[1]); w.w = pk2(b[2], b[3]); return w; }

namespace pg8 {
constexpr int BM = 256, BK = 64, HALF = 128, HTB = HALF * BK * 2, STAGE_BYTES = 8 * HTB, NXCD = 8, WGM = 4;
__device__ __forceinline__ int lds_byte(int r, int c) { const int st = (r >> 4) * 2 + (c >> 5), rr = r & 15, cc = c & 31, ob = rr * 64 + cc * 2; return st * 1024 + (ob ^ (((ob >> 9) & 1) << 5)); }
__device__ __forceinline__ void stage_rc(int b, int& R, int& C) { const int st = b / 1024, sb = b % 1024, swz = sb ^ (((sb >> 9) & 1) << 5); R = (st >> 1) * 16 + swz / 64; C = (st & 1) * 32 + (swz % 64) / 2; }
__device__ __forceinline__ int perm32(int rho) { const int n = rho >> 4, i = rho & 15; return 8 * (i >> 2) + 4 * n + (i & 3); }
struct Unit { int pm, pn; };
struct Gemm { const bf16_t* A; const bf16_t* Bt; int M, N, K; };
struct StaticOrder {
    int nM, nN, nwg, G, c;
    __device__ void init(int M, int N, int G_, int c_) { nM = M / BM; nN = N / BM; nwg = nM * nN; G = G_; c = c_; }
    __device__ bool next(int i, Unit& u) const {
        const long L = (long)i * G + c; if (L >= nwg) return false;
        int wgid = (int)L; { const int q = nwg / NXCD, r = nwg % NXCD, xcd = wgid % NXCD, off = wgid / NXCD; wgid = (xcd < r ? xcd * (q + 1) : r * (q + 1) + (xcd - r) * q) + off; }
        const int nig = WGM * nN, gid = wgid / nig, fm = gid * WGM, gsz = (nM - fm) < WGM ? (nM - fm) : WGM;
        u.pm = fm + ((wgid % nig) % gsz); u.pn = (wgid % nig) / gsz; return true;
    }
};

template <class Epi, class Sched>
__device__ __forceinline__ void gemm_phase(LAS unsigned char* lds, const Gemm g, const Sched& S, const Epi& E, const int wid) {
    const int lane = lane_fresh(), tid = wid * 64 + lane, wr = wid >> 2, wc = wid & 3, fr = lane & 15, fq = lane >> 4;
    const int K = g.K, nt = K / BK;
    unsigned voffA[2], voffB[2];
#pragma unroll
    for (int i = 0; i < 2; ++i) { int R, C; stage_rc(tid * 16 + i * 8192, R, C); const int Rb = 2 * (R & ~31) + perm32(R & 31);
        voffA[i] = (unsigned)(R * K + C) * 2u; voffB[i] = (unsigned)(Rb * K + C) * 2u; }
    const size_t kstep = (size_t)(BK * 2);
    const size_t hstep = (size_t)HALF * K * 2;
    const size_t tstep = 2 * hstep;
    const size_t bstep = (size_t)32 * K * 2;
    const unsigned ldsw = (unsigned)wid * 1024u;
    const int aoff = lds_byte(wr * 64 + fr, fq * 8), boff = lds_byte(wc * 32 + fr, fq * 8);
#define PG8_SA(b, h) (((b) * 2 + (h)) * HTB)
#define PG8_SB(b, h) ((4 + (b) * 2 + (h)) * HTB)
#define PG8_STAGE(bufoff, gbase, voff) do { _Pragma("unroll") for (int _i = 0; _i < 2; ++_i) \
        __builtin_amdgcn_global_load_lds((const unsigned*)((const char*)(gbase) + (voff)[_i]), (LAS unsigned*)(lds + (bufoff) + ldsw + _i * 8192), 16, 0, 0); } while (0)
#define PG8_LDA(dst, b, h) do { _Pragma("unroll") for (int m = 0; m < 4; ++m) _Pragma("unroll") for (int k = 0; k < 2; ++k) dst[m][k] = *(const LAS bf16x8*)(lds + PG8_SA(b, h) + aoff + m * 2048 + k * 1024); } while (0)
#define PG8_LDB(dst, b, h) do { _Pragma("unroll") for (int n = 0; n < 2; ++n) _Pragma("unroll") for (int k = 0; k < 2; ++k) dst[n][k] = *(const LAS bf16x8*)(lds + PG8_SB(b, h) + boff + n * 2048 + k * 1024); } while (0)
#define PG8_MMA(ai, bj, At, Bt) do { __builtin_amdgcn_s_setprio(1); _Pragma("unroll") for (int m = 0; m < 4; ++m) _Pragma("unroll") for (int n = 0; n < 2; ++n) _Pragma("unroll") for (int k = 0; k < 2; ++k) \
        acc[ai][bj][m][n] = __builtin_amdgcn_mfma_f32_16x16x32_bf16(Bt[n][k], At[m][k], acc[ai][bj][m][n], 0, 0, 0); __builtin_amdgcn_s_setprio(0); } while (0)
#define PG8_WAIT_V(n) asm volatile("s_waitcnt vmcnt(" #n ")" ::: "memory")
#define PG8_WAIT_L(n) asm volatile("s_waitcnt lgkmcnt(" #n ")" ::: "memory")
#define PG8_BAR __builtin_amdgcn_s_barrier()
#define PG8_SCHED __builtin_amdgcn_sched_barrier(0)
    Unit cur, nxt; int ui = 0;
    if (!S.next(0, cur)) return;
    f32x4 acc[2][2][4][2];
    if constexpr (Epi::INIT) E.init(acc, cur, 0, wr, wc, fr, fq);
    else {
#pragma unroll
    for (int a = 0; a < 2; ++a)
#pragma unroll
        for (int b = 0; b < 2; ++b)
#pragma unroll
            for (int m = 0; m < 4; ++m)
#pragma unroll
                for (int n = 0; n < 2; ++n) acc[a][b][m][n] = (f32x4){0.f, 0.f, 0.f, 0.f};
    }
    bf16x8 At[4][2], B0[2][2], B1[2][2];
    const char* cA = (const char*)g.A + (size_t)cur.pm * tstep; const char* cB = (const char*)g.Bt + (size_t)cur.pn * tstep;
    PG8_STAGE(PG8_SB(0, 0), cB, voffB); PG8_STAGE(PG8_SB(0, 1), cB + bstep, voffB); PG8_STAGE(PG8_SA(0, 0), cA, voffA); PG8_STAGE(PG8_SA(0, 1), cA + hstep, voffA);
    if (wr == 1) PG8_BAR;
    PG8_WAIT_V(2); PG8_BAR;
    PG8_STAGE(PG8_SB(1, 0), cB + kstep, voffB); PG8_STAGE(PG8_SA(1, 0), cA + kstep, voffA); PG8_STAGE(PG8_SB(1, 1), cB + bstep + kstep, voffB);
    PG8_WAIT_V(6); PG8_BAR;
    for (;;) {
        const bool has_next = S.next(ui + 1, nxt);
        const char* nA = has_next ? (const char*)g.A + (size_t)nxt.pm * tstep : cA; const char* nB = has_next ? (const char*)g.Bt + (size_t)nxt.pn * tstep : cB;
        for (int t = 0; t < nt; t += 2) {
            const bool last = (t == nt - 2);
            const char* a1 = cA + (size_t)(t + 1) * kstep;
            const char* a2 = last ? nA : cA + (size_t)(t + 2) * kstep; const char* b2 = last ? nB : cB + (size_t)(t + 2) * kstep;
            const char* a3 = a2 + kstep; const char* b3 = b2 + kstep;
            if constexpr (Epi::MID) { if (t == nt / 2) E.mid(acc, cur, ui, wr, wc, fr, fq); }
            PG8_LDB(B0, 0, 0); PG8_LDB(B1, 0, 1); PG8_SCHED; PG8_LDA(At, 0, 0); PG8_STAGE(PG8_SA(1, 1), a1 + hstep, voffA);
            PG8_WAIT_V(8); PG8_WAIT_L(0); PG8_BAR; PG8_MMA(0, 0, At, B0); PG8_MMA(0, 1, At, B1); PG8_BAR; PG8_SCHED;
            PG8_LDA(At, 0, 1); PG8_STAGE(PG8_SB(0, 0), b2, voffB); PG8_STAGE(PG8_SB(0, 1), b2 + bstep, voffB); PG8_STAGE(PG8_SA(0, 0), a2, voffA);
            PG8_WAIT_V(8); PG8_WAIT_L(0); PG8_BAR; PG8_MMA(1, 0, At, B0); PG8_MMA(1, 1, At, B1); PG8_BAR; PG8_SCHED;
            PG8_LDB(B0, 1, 0); PG8_LDB(B1, 1, 1); PG8_SCHED; PG8_LDA(At, 1, 0); PG8_STAGE(PG8_SA(0, 1), a2 + hstep, voffA);
            PG8_WAIT_V(8); PG8_WAIT_L(0); PG8_BAR; PG8_MMA(0, 0, At, B0); PG8_MMA(0, 1, At, B1); PG8_BAR; PG8_SCHED;
            PG8_LDA(At, 1, 1); PG8_STAGE(PG8_SB(1, 0), b3, voffB); PG8_STAGE(PG8_SB(1, 1), b3 + bstep, voffB); PG8_STAGE(PG8_SA(1, 0), a3, voffA);
            PG8_WAIT_V(8); PG8_WAIT_L(0); PG8_BAR; PG8_MMA(1, 0, At, B0); PG8_MMA(1, 1, At, B1); PG8_BAR; PG8_SCHED;
        }
        if (wr == 0) PG8_BAR;
        E(acc, cur, ui, wr, wc, fr, fq);
        if (!has_next) break;
        if constexpr (Epi::INIT) E.init(acc, nxt, ui + 1, wr, wc, fr, fq);
        else {
#pragma unroll
        for (int a = 0; a < 2; ++a)
#pragma unroll
            for (int b = 0; b < 2; ++b)
#pragma unroll
                for (int m = 0; m < 4; ++m)
#pragma unroll
                    for (int n = 0; n < 2; ++n) acc[a][b][m][n] = (f32x4){0.f, 0.f, 0.f, 0.f};
        }
        cur = nxt; cA = nA; cB = nB; ++ui;
        if (wr == 1) PG8_BAR;
    }
    PG8_WAIT_V(0);
    PG8_BAR;
#undef PG8_SA
#undef PG8_SB
#undef PG8_STAGE
#undef PG8_LDA
#undef PG8_LDB
#undef PG8_MMA
#undef PG8_WAIT_V
#undef PG8_WAIT_L
#undef PG8_BAR
#undef PG8_SCHED
}
}

struct EpiIn {
    static constexpr bool MID = false, INIT = false;
    bf16_t* P; const LAS float* rows; float* svg; float* knp; float* nvp; float* nks; float* nvs; LAS unsigned char* stg;
    template <int KIND>
    __device__ __forceinline__ void body(const f32x4 (&acc)[2][2][4][2], const pg8::Unit& u, int ui, int wr, int wc, int fr, int fq) const {
        const int row0 = u.pm * 256 + wr * 64 + fr;
        const int col0 = u.pn * 256 + wc * 64 + 8 * fq;
        const LAS float* rsl = rows + ui * 256 + wr * 64 + fr;
        const int sl = fq * 16 + fr, srow = sl >> 3, spc = sl & 7;
        LAS unsigned char* sw = stg ? stg + (wr * 4 + wc) * 2304 : nullptr;
#pragma unroll
        for (int ai = 0; ai < 2; ++ai)
#pragma unroll
            for (int m = 0; m < 4; ++m) {
                const int row = row0 + ai * 128 + m * 16;
                const float rs = rsl[ai * 128 + m * 16];
                bf16_t* rowp = P + (size_t)row * DPROJ + col0;
                float* dst = nullptr;
                if (KIND == 4) {
                    float* bp = (u.pn == 5) ? nvp : knp; float* bs = (u.pn == 5) ? nvs : nks;
                    if (u.pm < 128) { if ((u.pm & 7) == 7 && ai == 1) dst = bp + (size_t)((u.pm >> 3) * 128 + wr * 64 + m * 16 + fr) * 256 + wc * 64 + 8 * fq; }
                    else { const int sr = row - NP; dst = bs + (size_t)((sr >> 5) * 128 + 96 + (sr & 31)) * 256 + wc * 64 + 8 * fq; }
                }
                float s1 = 0.f, s2 = 0.f;
#pragma unroll
                for (int bj = 0; bj < 2; ++bj) {
                    f32x4 v0 = acc[ai][bj][m][0] * rs, v1 = acc[ai][bj][m][1] * rs;
                    if (KIND == 1) { v0 = silu4(v0); v1 = silu4(v1); }
                    if (KIND == 2 || KIND == 3) { v0 = gelu4(v0); v1 = gelu4(v1); }
                    if (KIND == 3) { s1 += (v0[0] + v0[1]) + (v0[2] + v0[3]) + (v1[0] + v1[1]) + (v1[2] + v1[3]);
                        s2 += (v0[0] * v0[0] + v0[1] * v0[1]) + (v0[2] * v0[2] + v0[3] * v0[3]) + (v1[0] * v1[0] + v1[1] * v1[1]) + (v1[2] * v1[2] + v1[3] * v1[3]); }
                    if (sw) *(LAS u32x4*)(sw + fr * 144 + bj * 64 + fq * 16) = pack8(v0, v1);
                    else *(u32x4*)(rowp + bj * 32) = pack8(v0, v1);
                    if (KIND == 4) { if (dst) { *(f32x4*)(dst + bj * 32) = v0; *(f32x4*)(dst + bj * 32 + 4) = v1; } }
                }
                if (sw) {
                    bf16_t* gb = P + (size_t)(u.pm * 256 + ai * 128 + wr * 64 + m * 16 + srow) * DPROJ + u.pn * 256 + wc * 64 + spc * 8;
                    const u32x4 w0 = *(const LAS u32x4*)(sw + srow * 144 + spc * 16), w1 = *(const LAS u32x4*)(sw + (srow + 8) * 144 + spc * 16);
                    *(u32x4*)gb = w0; *(u32x4*)(gb + (size_t)8 * DPROJ) = w1;
                }
                if (KIND == 3) {
                    s1 = fq_sum(s1); s2 = fq_sum(s2);
                    if (fq == 0) *(f32x2*)(svg + ((size_t)row * 16 + (u.pn - 14) * 4 + wc) * 2) = (f32x2){s1, s2};
                }
            }
    }
    __device__ __forceinline__ void operator()(const f32x4 (&acc)[2][2][4][2], const pg8::Unit& u, int ui, int wr, int wc, int fr, int fq) const {
        const int pn = u.pn;
        if (pn < 4) body<0>(acc, u, ui, wr, wc, fr, fq);
        else if (pn < 6) body<4>(acc, u, ui, wr, wc, fr, fq);
        else if (pn < 10 || pn >= 18) body<1>(acc, u, ui, wr, wc, fr, fq);
        else if (pn < 14) body<2>(acc, u, ui, wr, wc, fr, fq);
        else body<3>(acc, u, ui, wr, wc, fr, fq);
    }
};

struct EpiOut {
    static constexpr bool MID = true, INIT = true;
    float* out; bf16_t* xb; float* ssx; const LAS float* rows; int last;
    __device__ __forceinline__ void init(f32x4 (&acc)[2][2][4][2], const pg8::Unit& u, int ui, int wr, int wc, int fr, int fq) const {
        int row0 = u.pm * 256 + wr * 64 + fr;
        asm volatile("" : "+v"(row0));
        const int col0 = u.pn * 256 + wc * 64 + 8 * fq;
        const LAS float* rl = rows + ui * 768 + ((row0 - u.pm * 256));
#pragma unroll
        for (int ai = 0; ai < 2; ++ai)
#pragma unroll
            for (int m = 0; m < 4; ++m) {
                const int row = row0 + ai * 128 + m * 16;
                const bf16_t* base = xb + (size_t)row * DM + col0;
#pragma unroll
                for (int bj = 0; bj < 2; ++bj) { const u32x4 w = *(const u32x4*)(base + bj * 32);
                    acc[ai][bj][m][0] = (f32x4){bf_lo(w.x), bf_hi(w.x), bf_lo(w.y), bf_hi(w.y)}; acc[ai][bj][m][1] = (f32x4){bf_lo(w.z), bf_hi(w.z), bf_lo(w.w), bf_hi(w.w)}; }
            }
#pragma unroll
        for (int ai = 0; ai < 2; ++ai)
#pragma unroll
            for (int m = 0; m < 4; ++m) {
                const float ia = rl[ai * 128 + m * 16];
#pragma unroll
                for (int bj = 0; bj < 2; ++bj)
#pragma unroll
                    for (int n = 0; n < 2; ++n) acc[ai][bj][m][n] = acc[ai][bj][m][n] * ia;
            }
    }
    __device__ __forceinline__ void mid(f32x4 (&acc)[2][2][4][2], const pg8::Unit& u, int ui, int wr, int wc, int fr, int fq) const {
        int rt = wr * 64 + fr;
        asm volatile("" : "+v"(rt));
        const LAS float* rl = rows + ui * 768 + 256 + rt;
#pragma unroll
        for (int ai = 0; ai < 2; ++ai)
#pragma unroll
            for (int m = 0; m < 4; ++m) {
                const float ratio = rl[ai * 128 + m * 16];
#pragma unroll
                for (int bj = 0; bj < 2; ++bj)
#pragma unroll
                    for (int n = 0; n < 2; ++n) acc[ai][bj][m][n] = acc[ai][bj][m][n] * ratio;
            }
    }
    __device__ __forceinline__ void operator()(const f32x4 (&acc)[2][2][4][2], const pg8::Unit& u, int ui, int wr, int wc, int fr, int fq) const {
        const int row0 = u.pm * 256 + wr * 64 + fr;
        const int col0 = u.pn * 256 + wc * 64 + 8 * fq;
        const LAS float* rl = rows + ui * 768 + 512 + wr * 64 + fr;
#pragma unroll
        for (int ai = 0; ai < 2; ++ai)
#pragma unroll
            for (int m = 0; m < 4; ++m) {
                const int row = row0 + ai * 128 + m * 16;
                const float rb = rl[ai * 128 + m * 16];
                float* o = out + (size_t)row * DM + col0; bf16_t* xo = xb + (size_t)row * DM + col0;
                float ss = 0.f;
#pragma unroll
                for (int bj = 0; bj < 2; ++bj) {
                    const f32x4 v0 = acc[ai][bj][m][0] * rb, v1 = acc[ai][bj][m][1] * rb;
                    if (last) { *(f32x4*)(o + bj * 32) = v0; *(f32x4*)(o + bj * 32 + 4) = v1; }
                    else *(u32x4*)(xo + bj * 32) = pack8(v0, v1);
                    ss += (v0[0] * v0[0] + v0[1] * v0[1]) + (v0[2] * v0[2] + v0[3] * v0[3]) + (v1[0] * v1[0] + v1[1] * v1[1]) + (v1[2] * v1[2] + v1[3] * v1[3]);
                }
                ss = fq_sum(ss);
                if (fq == 0) ssx[(size_t)row * 32 + u.pn * 4 + wc] = ss;
                asm volatile("" ::: "memory");
            }
    }
};

struct TItem { const float* W; const float* gk; bf16_t* WT; int N, k0, n0; };
__device__ __forceinline__ TItem p0_item(const Params& p, bf16_t* WIN, bf16_t* WOUT, int it) {
    constexpr int I_IN = (DM / 64) * (DPROJ / 32), I_OUT = (DM / 64) * (DM / 32), I_L = I_IN + I_OUT;
    const int l = it / I_L; int r = it - l * I_L; TItem t;
    if (r < I_IN) { const int nblk = DPROJ / 32, kb = r / nblk; t.k0 = 64 * kb; t.n0 = 32 * (r - kb * nblk); t.N = DPROJ; t.W = p.w_in + (size_t)l * DM * DPROJ; t.gk = p.norm_in + l * DM + t.k0; t.WT = WIN + (size_t)l * DPROJ * DM; }
    else { r -= I_IN; const int nblk = DM / 32, kb = r / nblk; t.k0 = 64 * kb; t.n0 = 32 * (r - kb * nblk); t.N = DM; t.W = p.w_out + (size_t)l * DM * DM;
        t.gk = (t.k0 < 1024) ? p.norm_attn + l * 1024 + t.k0 : p.norm_gmlp + l * 1024 + (t.k0 - 1024); t.WT = WOUT + (size_t)l * DM * DM; }
    return t;
}
__device__ __forceinline__ void p0_load(const TItem& t, f32x4 (&v)[8], int lane) {
#pragma unroll
    for (int i = 0; i < 8; ++i) { const int kk = 8 * i + (lane >> 3); v[i] = *(const f32x4*)(t.W + (size_t)(t.k0 + kk) * t.N + t.n0 + 4 * (lane & 7)) * t.gk[kk]; }
}
__device__ __forceinline__ void p0_emit(const TItem& t, const f32x4 (&v)[8], LAS float* scr, int lane) {
#pragma unroll
    for (int i = 0; i < 8; ++i) { LAS float* d = scr + (8 * i + (lane >> 3)) * 33 + 4 * (lane & 7); d[0] = v[i][0]; d[1] = v[i][1]; d[2] = v[i][2]; d[3] = v[i][3]; }
    asm volatile("s_waitcnt lgkmcnt(0)" ::: "memory");
    const int c = lane & 7;
#pragma unroll
    for (int j = 0; j < 4; ++j) { const int n = (lane >> 3) + 8 * j; const LAS float* sp = scr + (8 * c) * 33 + n;
        u32x4 o; o.x = pk2(sp[0 * 33], sp[1 * 33]); o.y = pk2(sp[2 * 33], sp[3 * 33]); o.z = pk2(sp[4 * 33], sp[5 * 33]); o.w = pk2(sp[6 * 33], sp[7 * 33]);
        *(u32x4*)(t.WT + (size_t)(t.n0 + n) * DM + t.k0 + 8 * c) = o; }
    asm volatile("s_waitcnt lgkmcnt(0)" ::: "memory");
}

__device__ __forceinline__ void prologue(LAS unsigned char* lds, const Params& p, int tid, int wave, int lane, int bid, int G) {
    lane = lane_fresh(); tid = wave * 64 + lane;
    unsigned char* ws = p.ws;
    bf16_t* WIN = (bf16_t*)(ws + WS_WIN); bf16_t* WOUT = (bf16_t*)(ws + WS_WOUT); bf16_t* XB = (bf16_t*)(ws + WS_XB);
    float* SSX = (float*)(ws + WS_SSX);
    LAS float* scr = (LAS float*)(lds + wave * 17408);
    const int gw = bid * 8 + wave, NGW = G * 8;
    constexpr int NIT = DEPTH * ((DM / 64) * (DPROJ / 32) + (DM / 64) * (DM / 32));
    for (int it = gw; it < NIT; it += 2 * NGW) {
        const bool two = it + NGW < NIT;
        const TItem ta = p0_item(p, WIN, WOUT, it), tb = p0_item(p, WIN, WOUT, two ? it + NGW : it);
        f32x4 va[8], vb[8];
        p0_load(ta, va, lane); if (two) p0_load(tb, vb, lane);
        p0_emit(ta, va, scr, lane); if (two) p0_emit(tb, vb, scr + 64 * 33, lane);
    }
    for (int row = gw; row < MT; row += 2 * NGW) {
        const int row2 = row + NGW; const bool two = row2 < MT; const int rb = two ? row2 : row;
        const f32x4* xa = (const f32x4*)(row < NP ? p.x_prompt + (size_t)row * DM : p.x_sample + (size_t)(row - NP) * DM) + lane;
        const f32x4* xb2 = (const f32x4*)(rb < NP ? p.x_prompt + (size_t)rb * DM : p.x_sample + (size_t)(rb - NP) * DM) + lane;
        f32x4 va[8], vb[8];
#pragma unroll
        for (int j = 0; j < 8; ++j) va[j] = xa[64 * j];
#pragma unroll
        for (int j = 0; j < 8; ++j) vb[j] = xb2[64 * j];
        u32x2* oa = (u32x2*)(XB + (size_t)row * DM) + lane; u32x2* ob = (u32x2*)(XB + (size_t)rb * DM) + lane;
        float sa = 0.f, sb = 0.f;
#pragma unroll
        for (int j = 0; j < 8; ++j) { const f32x4 v = va[j]; sa += (v[0] * v[0] + v[1] * v[1]) + (v[2] * v[2] + v[3] * v[3]); u32x2 w; w.x = pk2(v[0], v[1]); w.y = pk2(v[2], v[3]); oa[64 * j] = w; }
        if (two) {
#pragma unroll
            for (int j = 0; j < 8; ++j) { const f32x4 v = vb[j]; sb += (v[0] * v[0] + v[1] * v[1]) + (v[2] * v[2] + v[3] * v[3]); u32x2 w; w.x = pk2(v[0], v[1]); w.y = pk2(v[2], v[3]); ob[64 * j] = w; }
        }
        sa = wave_sum(sa); sb = wave_sum(sb);
        if (lane < 32) { SSX[(size_t)row * 32 + lane] = (lane == 0) ? sa : 0.f; if (two) SSX[(size_t)row2 * 32 + lane] = (lane == 0) ? sb : 0.f; }
    }
    for (int seg = bid; seg < 256; seg += G) {
        const int kv = seg >> 7, lb = seg & 127;
        const f32x4* src = (const f32x4*)((kv ? p.cache_v : p.cache_k) + ((size_t)lb * 128 + 32) * 256);
        f32x4* dst = (f32x4*)(p.out + (kv ? OUT_NVS : OUT_NKS) + (size_t)lb * 128 * 256);
        for (int i = tid; i < 96 * 64; i += 512) dst[i] = src[i];
    }
}

constexpr int L_KS = 0, L_VT = 27648, L_WS = 73728, L_MUR = 108544, L_BIAS = 131072;
#define MFMA32(a, b, c) __builtin_amdgcn_mfma_f32_32x32x16_bf16((a), (b), (c), 0, 0, 0)
__device__ __forceinline__ bf16x8 pack_step(const f32x16& x, int s) {
    u32x4 w; w.x = pk2(x[8 * s], x[8 * s + 1]); w.y = pk2(x[8 * s + 2], x[8 * s + 3]); w.z = pk2(x[8 * s + 4], x[8 * s + 5]); w.w = pk2(x[8 * s + 6], x[8 * s + 7]);
    return __builtin_bit_cast(bf16x8, w);
}

__device__ __forceinline__ void attn_task(LAS unsigned char* lds, const Params& p, const bf16_t* P, bf16_t* Y, float* ssa, int l, bool sample, int b, int c, int kvh, int tid, int wave, int lane) {
    lane = lane_fresh(); tid = wave * 64 + lane;
    LAS bf16_t* KS = (LAS bf16_t*)(lds + L_KS);
    LAS bf16_t* VT = (LAS bf16_t*)(lds + L_VT);
    const LAS float* BIAS = (const LAS float*)(lds + L_BIAS);
    const int nk = sample ? 160 : 192;
    const int jmin = sample ? 0 : (c >= 2 ? 0 : (2 - c) * 64);
    for (int id = tid; id < nk * 8; id += 512) {
        const int j = id >> 3, ch = id & 7;
        if (j >= jmin) {
            u32x4 w;
            if (sample && j < 128) { const float* src = p.cache_k + ((((size_t)l * 32 + b) * 128 + j) * 4 + kvh) * 64 + ch * 8; w = pack8(*(const f32x4*)src, *(const f32x4*)(src + 4)); }
            else { const size_t row = sample ? (size_t)NP + b * 32 + (j - 128) : (size_t)b * 2048 + (c - 2) * 64 + j; w = *(const u32x4*)(P + row * DPROJ + O_K + kvh * 64 + ch * 8); }
            *(LAS u32x4*)(KS + j * 72 + ch * 8) = w;
        }
    }
    for (int id = tid; id < nk * 8; id += 512) {
        const int ch = id / nk, j = id - ch * nk;
        if (j >= jmin) {
            u32x4 w;
            if (sample && j < 128) { const float* src = p.cache_v + ((((size_t)l * 32 + b) * 128 + j) * 4 + kvh) * 64 + ch * 8; w = pack8(*(const f32x4*)src, *(const f32x4*)(src + 4)); }
            else { const size_t row = sample ? (size_t)NP + b * 32 + (j - 128) : (size_t)b * 2048 + (c - 2) * 64 + j; w = *(const u32x4*)(P + row * DPROJ + O_V + kvh * 64 + ch * 8); }
#pragma unroll
            for (int e = 0; e < 4; ++e) { VT[(ch * 8 + 2 * e) * 200 + j] = (bf16_t)(w[e] & 0xffffu); VT[(ch * 8 + 2 * e + 1) * 200 + j] = (bf16_t)(w[e] >> 16); }
        }
    }
    __syncthreads();
    const int r = lane & 31, h = lane >> 5;
    const bool active = sample ? (wave < 4) : true;
    if (active) {
        const int g = sample ? wave : (wave >> 1), qh = sample ? 0 : (wave & 1);
        const int head = kvh * 4 + g, i = 32 * qh + r;
        const size_t qrow = sample ? (size_t)NP + b * 32 + i : (size_t)b * 2048 + c * 64 + i;
        bf16x8 qf[4];
#pragma unroll
        for (int s = 0; s < 4; ++s) qf[s] = *(const bf16x8*)(P + qrow * DPROJ + O_Q + head * 64 + 16 * s + 8 * h);
        const bf16_t* gp = P + qrow * DPROJ + O_GA + head * 64 + 8 * h;
        u32x4 gwv[4];
#pragma unroll
        for (int e = 0; e < 4; ++e) gwv[e] = *(const u32x4*)(gp + 16 * e);
        const int T0 = jmin >> 5, NT = nk >> 5;
        f32x16 st[6];
#pragma unroll
        for (int T = 0; T < 6; ++T) {
            f32x16 acc;
            if (T >= T0 && T < NT) {
#pragma unroll
                for (int e = 0; e < 16; ++e) acc[e] = 0.f;
#pragma unroll
                for (int s = 0; s < 4; ++s) { const bf16x8 a = *(const LAS bf16x8*)(KS + (32 * T + r) * 72 + 16 * s + 8 * h); acc = MFMA32(a, qf[s], acc); }
            } else {
#pragma unroll
                for (int e = 0; e < 16; ++e) acc[e] = -1e30f;
            }
            st[T] = acc;
        }
        const float sc = 0.125f * LOG2E;
        const LAS float* bl = BIAS + head * 256 + 63 - i + 4 * h;
        float mx = -3e38f;
#pragma unroll
        for (int T = 0; T < 6; ++T)
            if (T >= T0 && T < NT) {
#pragma unroll
                for (int e = 0; e < 16; ++e) { const float v = st[T][e] * sc + bl[32 * T + (e & 3) + 8 * (e >> 2)]; st[T][e] = v; mx = fmaxf(mx, v); }
                }
        mx = fmaxf(mx, __shfl_xor(mx, 32));
        const float sink2 = p.sinks[l * 16 + head] * LOG2E;
        mx = fmaxf(mx, sink2);
        float sum = 0.f;
#pragma unroll
        for (int T = 0; T < 6; ++T)
#pragma unroll
            for (int e = 0; e < 16; ++e) { const float pv = __builtin_amdgcn_exp2f(st[T][e] - mx); st[T][e] = pv; sum += pv; }
        sum += __shfl_xor(sum, 32);
        sum += __builtin_amdgcn_exp2f(sink2 - mx);
        const float inv = 1.0f / sum;
        f32x16 o[2];
#pragma unroll
        for (int e = 0; e < 16; ++e) { o[0][e] = 0.f; o[1][e] = 0.f; }
#pragma unroll
        for (int T = 0; T < 6; ++T)
            if (T >= T0 && T < NT) {
#pragma unroll
                for (int s = 0; s < 2; ++s) {
                    const bf16x8 xs = pack_step(st[T], s);
#pragma unroll
                    for (int dt = 0; dt < 2; ++dt) {
                        const LAS bf16_t* vp = VT + (32 * dt + r) * 200 + 32 * T + 16 * s + 4 * h;
                        const s16x4 lo = *(const LAS s16x4*)vp, hi = *(const LAS s16x4*)(vp + 8);
                        const bf16x8 pa = __builtin_shufflevector(lo, hi, 0, 1, 2, 3, 4, 5, 6, 7);
                        o[dt] = MFMA32(pa, xs, o[dt]);
                    }
                }
                }
        float ss = 0.f;
        bf16_t* yp = Y + qrow * DM + head * 64 + 8 * h;
#pragma unroll
        for (int dt = 0; dt < 2; ++dt)
#pragma unroll
            for (int pr = 0; pr < 2; ++pr) {
                float a[4], bq[4];
#pragma unroll
                for (int k = 0; k < 4; ++k) { a[k] = o[dt][8 * pr + k] * inv; bq[k] = o[dt][8 * pr + 4 + k] * inv; }
                ss += ((a[0] * a[0] + a[1] * a[1]) + (a[2] * a[2] + a[3] * a[3])) + ((bq[0] * bq[0] + bq[1] * bq[1]) + (bq[2] * bq[2] + bq[3] * bq[3]));
#pragma unroll
                for (int k = 0; k < 4; ++k) swap_halves(a[k], bq[k]);
                const u32x4 gw = gwv[2 * dt + pr];
                u32x4 w; w.x = pk2(a[0] * bf_lo(gw.x), a[1] * bf_hi(gw.x)); w.y = pk2(a[2] * bf_lo(gw.y), a[3] * bf_hi(gw.y));
                w.z = pk2(bq[0] * bf_lo(gw.z), bq[1] * bf_hi(gw.z)); w.w = pk2(bq[2] * bf_lo(gw.w), bq[3] * bf_hi(gw.w));
                *(u32x4*)(yp + 32 * dt + 16 * pr) = w;
            }
        ss += __shfl_xor(ss, 32);
        if (h == 0) ssa[qrow * 16 + head] = ss;
    }
    __syncthreads();
}

__device__ __forceinline__ void attn_run(LAS unsigned char* lds, const Params& p, const bf16_t* P, bf16_t* Y, float* ssa, int l, int t0, int t1, int wave) {
    if (t0 >= t1) return;
    const int lane = lane_fresh(), tid = wave * 64 + lane;
    LAS bf16_t* KS = (LAS bf16_t*)(lds + L_KS);
    LAS bf16_t* VT = (LAS bf16_t*)(lds + L_VT);
    const LAS float* BIAS = (const LAS float*)(lds + L_BIAS);
    const int r = lane & 31, h = lane >> 5;
    const int jk = tid >> 3, chk = tid & 7;
    const int jv = jk, chv = chk;
    u32x4 pk = (u32x4){0u, 0u, 0u, 0u}, pv = pk;
    bf16x8 qn[4];
#pragma unroll
    for (int s = 0; s < 4; ++s) qn[s] = (bf16x8){0, 0, 0, 0, 0, 0, 0, 0};
    int prev_bk = -1, prev_c = -100;
    for (int t = t0; t < t1; ++t) {
        const int c = t & 31, bk = t >> 5, kvh = bk & 3, b = bk >> 2;
        const bool cont = (bk == prev_bk) && (c == prev_c + 1);
        const bf16_t* Pk = P + ((size_t)b * 2048 + jk) * DPROJ + O_K + kvh * 64 + chk * 8;
        const bf16_t* Pv = P + ((size_t)b * 2048 + jv) * DPROJ + O_V + kvh * 64 + chv * 8;
        if (cont) {
            const int slot = c % 3;
            *(LAS u32x4*)(KS + (slot * 64 + jk) * 72 + chk * 8) = pk;
            *(LAS u32x4*)(VT + (slot * 64 + jv) * 72 + chv * 8) = pv;
        } else {
            for (int q = (c >= 2 ? c - 2 : 0); q <= c; ++q) {
                const int slot = q % 3;
                const u32x4 wk = *(const u32x4*)(Pk + (size_t)q * 64 * DPROJ), wv = *(const u32x4*)(Pv + (size_t)q * 64 * DPROJ);
                *(LAS u32x4*)(KS + (slot * 64 + jk) * 72 + chk * 8) = wk;
                *(LAS u32x4*)(VT + (slot * 64 + jv) * 72 + chv * 8) = wv;
            }
        }
        __syncthreads();
        {
            const int g = wave >> 1, qh = wave & 1;
            const int head = kvh * 4 + g, i = 32 * qh + r;
            const size_t qrow = (size_t)b * 2048 + c * 64 + i;
            const bf16_t* qp = P + qrow * DPROJ + O_Q + head * 64 + 8 * h;
            bf16x8 qf[4];
            if (cont) {
#pragma unroll
                for (int s = 0; s < 4; ++s) qf[s] = qn[s];
            } else {
#pragma unroll
                for (int s = 0; s < 4; ++s) qf[s] = *(const bf16x8*)(qp + 16 * s);
            }
            if (t + 1 < t1 && ((t + 1) >> 5) == bk) {
                pk = *(const u32x4*)(Pk + (size_t)(c + 1) * 64 * DPROJ); pv = *(const u32x4*)(Pv + (size_t)(c + 1) * 64 * DPROJ);
#pragma unroll
                for (int s = 0; s < 4; ++s) qn[s] = *(const bf16x8*)(qp + (size_t)64 * DPROJ + 16 * s);
            }
            const int srow = lane >> 3, spc = lane & 7;
            LAS unsigned char* gt = lds + 55296 + wave * 9216; LAS unsigned char* yt = gt + 4608;
            const size_t qrow0 = (size_t)b * 2048 + c * 64 + 32 * qh;
            u32x4 gwv[4];
#pragma unroll
            for (int e = 0; e < 4; ++e) gwv[e] = *(const u32x4*)(P + (qrow0 + srow + 8 * e) * DPROJ + O_GA + head * 64 + spc * 8);
            const int T0 = c >= 2 ? 0 : 2 * (2 - c);
            const int sl0 = (c + 1) % 3, sl1 = (c + 2) % 3, sl2 = c % 3;
            f32x16 st[6];
#pragma unroll
            for (int T = 0; T < 6; ++T) {
                f32x16 acc;
                const int prow = 64 * ((T >> 1) == 0 ? sl0 : ((T >> 1) == 1 ? sl1 : sl2)) + 32 * (T & 1);
                if (T >= T0) {
#pragma unroll
                    for (int e = 0; e < 16; ++e) acc[e] = 0.f;
#pragma unroll
                    for (int s = 0; s < 4; ++s) { const bf16x8 a = *(const LAS bf16x8*)(KS + (prow + r) * 72 + 16 * s + 8 * h); acc = MFMA32(a, qf[s], acc); }
                } else {
#pragma unroll
                    for (int e = 0; e < 16; ++e) acc[e] = -1e30f;
                }
                st[T] = acc;
            }
            const float sc = 0.125f * LOG2E;
            const LAS float* bl = BIAS + head * 256 + 63 - i + 4 * h;
            float mx = -3e38f;
#pragma unroll
            for (int T = 0; T < 6; ++T)
                if (T >= T0) {
#pragma unroll
                    for (int e = 0; e < 16; ++e) { const float v = st[T][e] * sc + bl[32 * T + (e & 3) + 8 * (e >> 2)]; st[T][e] = v; mx = fmaxf(mx, v); }
                }
            mx = fmaxf(mx, __shfl_xor(mx, 32));
            const float sink2 = p.sinks[l * 16 + head] * LOG2E;
            mx = fmaxf(mx, sink2);
            float sum = 0.f;
#pragma unroll
            for (int T = 0; T < 6; ++T)
#pragma unroll
                for (int e = 0; e < 16; ++e) { const float pe = __builtin_amdgcn_exp2f(st[T][e] - mx); st[T][e] = pe; sum += pe; }
            sum += __shfl_xor(sum, 32);
            sum += __builtin_amdgcn_exp2f(sink2 - mx);
            const float inv = 1.0f / sum;
            f32x16 o[2];
#pragma unroll
            for (int e = 0; e < 16; ++e) { o[0][e] = 0.f; o[1][e] = 0.f; }
#pragma unroll
            for (int T = 0; T < 6; ++T)
                if (T >= T0) {
                    const int prow = 64 * ((T >> 1) == 0 ? sl0 : ((T >> 1) == 1 ? sl1 : sl2)) + 32 * (T & 1);
#pragma unroll
                    for (int s = 0; s < 2; ++s) {
                        const bf16x8 xs = pack_step(st[T], s);
#pragma unroll
                        for (int dt = 0; dt < 2; ++dt) {
                            const LAS bf16_t* vp = VT + (prow + 16 * s + 4 * h + ((lane & 15) >> 2)) * 72 + 32 * dt + 16 * ((lane >> 4) & 1) + 4 * (lane & 3);
                            const s16x4 lo = __builtin_amdgcn_ds_read_tr16_b64_v4i16((LAS s16x4*)vp), hi = __builtin_amdgcn_ds_read_tr16_b64_v4i16((LAS s16x4*)(vp + 8 * 72));
                            const bf16x8 pa = __builtin_shufflevector(lo, hi, 0, 1, 2, 3, 4, 5, 6, 7);
                            o[dt] = MFMA32(pa, xs, o[dt]);
                        }
                    }
                }
            float ss = 0.f;
#pragma unroll
            for (int e = 0; e < 4; ++e) *(LAS u32x4*)(gt + (srow + 8 * e) * 144 + spc * 16) = gwv[e];
#pragma unroll
            for (int dt = 0; dt < 2; ++dt)
#pragma unroll
                for (int pr = 0; pr < 2; ++pr) {
                    float a[4], bq[4];
#pragma unroll
                    for (int k = 0; k < 4; ++k) { a[k] = o[dt][8 * pr + k] * inv; bq[k] = o[dt][8 * pr + 4 + k] * inv; }
                    ss += ((a[0] * a[0] + a[1] * a[1]) + (a[2] * a[2] + a[3] * a[3])) + ((bq[0] * bq[0] + bq[1] * bq[1]) + (bq[2] * bq[2] + bq[3] * bq[3]));
#pragma unroll
                    for (int k = 0; k < 4; ++k) swap_halves(a[k], bq[k]);
                    const u32x4 gw = *(const LAS u32x4*)(gt + r * 144 + (4 * dt + 2 * pr + h) * 16);
                    u32x4 w; w.x = pk2(a[0] * bf_lo(gw.x), a[1] * bf_hi(gw.x)); w.y = pk2(a[2] * bf_lo(gw.y), a[3] * bf_hi(gw.y));
                    w.z = pk2(bq[0] * bf_lo(gw.z), bq[1] * bf_hi(gw.z)); w.w = pk2(bq[2] * bf_lo(gw.w), bq[3] * bf_hi(gw.w));
                    *(LAS u32x4*)(yt + r * 144 + (4 * dt + 2 * pr + h) * 16) = w;
                }
#pragma unroll
            for (int e = 0; e < 4; ++e) *(u32x4*)(Y + (qrow0 + srow + 8 * e) * DM + head * 64 + spc * 8) = *(const LAS u32x4*)(yt + (srow + 8 * e) * 144 + spc * 16);
            ss += __shfl_xor(ss, 32);
            if (h == 0) ssa[qrow * 16 + head] = ss;
        }
        __syncthreads();
        prev_bk = bk; prev_c = c;
    }
}

__device__ __forceinline__ int vgt_off(int sidx) { return sidx * 18432; }
__device__ __forceinline__ void gmlp_task(LAS unsigned char* lds, const Params& p, const bf16_t* P, bf16_t* Y, const float* svg, float* ssb, int l, bool sample, int b, int g, int q, int tid, int wave, int lane, bool load_ws = true) {
    lane = lane_fresh(); tid = wave * 64 + lane;
    LAS bf16_t* WSL = (LAS bf16_t*)(lds + L_WS);
    LAS f32x2* MUR = (LAS f32x2*)(lds + L_MUR);
    if (load_ws) {
        const float* wsp = p.w_spatial + (size_t)(l * 16 + g) * 128 * 128;
#pragma unroll
        for (int k = 0; k < 4; ++k) {
            const int id = tid + 512 * k, i = id >> 4, j0 = (id & 15) * 8;
            f32x4 a = *(const f32x4*)(wsp + i * 128 + j0), bb = *(const f32x4*)(wsp + i * 128 + j0 + 4);
#pragma unroll
            for (int e = 0; e < 4; ++e) { if (j0 + e > i) a[e] = 0.f; if (j0 + 4 + e > i) bb[e] = 0.f; }
            *(LAS u32x4*)(WSL + i * 136 + j0) = pack8(a, bb);
        }
    }
    const int L = sample ? 32 : 128;
    const int r = lane & 31, h = lane >> 5;
    const float* lg = p.ln_v_g + l * 1024 + g * 64; const float* lb = p.ln_v_b + l * 1024 + g * 64;
    u32x4 wraw[4][2];
#pragma unroll
    for (int sub = 0; sub < 4; ++sub) {
        const int cidx = q * 4 + sub;
        const size_t row0 = sample ? (size_t)NP + cidx * 32 : (size_t)b * 2048 + cidx * 128;
#pragma unroll
        for (int k = 0; k < 2; ++k) {
            const int id = tid + 512 * k;
            if (id < L * 8) { const int ch = id & 7, j = id >> 3; wraw[sub][k] = *(const u32x4*)(P + (row0 + j) * DPROJ + O_VG + g * 64 + ch * 8); }
            else wraw[sub][k] = (u32x4){0u, 0u, 0u, 0u};
        }
    }
#pragma unroll
    for (int sub = 0; sub < 4; ++sub) {
        const int cidx = q * 4 + sub;
        const size_t row0 = sample ? (size_t)NP + cidx * 32 : (size_t)b * 2048 + cidx * 128;
        if ((tid >> 2) < L) {
            const int j = tid >> 2, qq = tid & 3;
            const f32x4* sp = (const f32x4*)(svg + ((row0 + j) * 16 + qq * 4) * 2);
            const f32x4 a = sp[0], bq = sp[1];
            float s1 = (a[0] + a[2]) + (bq[0] + bq[2]), s2 = (a[1] + a[3]) + (bq[1] + bq[3]);
            s1 += __shfl_xor(s1, 1); s1 += __shfl_xor(s1, 2); s2 += __shfl_xor(s2, 1); s2 += __shfl_xor(s2, 2);
            const float mean = s1 * (1.0f / 1024.0f), var = s2 * (1.0f / 1024.0f) - mean * mean;
            if (qq == 0) MUR[sub * 128 + j] = (f32x2){mean, __builtin_amdgcn_rsqf(var + EPS)};
        }
    }
    __syncthreads();
#pragma unroll
    for (int sub = 0; sub < 4; ++sub) {
        const int cidx = q * 4 + sub;
        const size_t row0 = sample ? (size_t)NP + cidx * 32 : (size_t)b * 2048 + cidx * 128;
        LAS bf16_t* VGT = (LAS bf16_t*)(lds + vgt_off(sub));
#pragma unroll
        for (int k = 0; k < 2; ++k) {
            const int id = tid + 512 * k;
            if (id >= L * 8) continue;
            const int ch = id & 7, j = id >> 3;
            const f32x2 mr = MUR[sub * 128 + j];
            const float mean = mr.x, rstd = mr.y;
            const u32x4 w = wraw[sub][k];
            const f32x4 g0 = *(const f32x4*)(lg + ch * 8), g1 = *(const f32x4*)(lg + ch * 8 + 4), b0 = *(const f32x4*)(lb + ch * 8), b1 = *(const f32x4*)(lb + ch * 8 + 4);
            f32x4 v0 = (f32x4){bf_lo(w.x), bf_hi(w.x), bf_lo(w.y), bf_hi(w.y)}, v1 = (f32x4){bf_lo(w.z), bf_hi(w.z), bf_lo(w.w), bf_hi(w.w)};
            v0 = (v0 - mean) * rstd * g0 + b0; v1 = (v1 - mean) * rstd * g1 + b1;
            if (sample) { float* dst = p.out + OUT_VGS + ((((size_t)l * 32 + cidx) * 32 + j) * 16 + g) * 64 + ch * 8; *(f32x4*)dst = v0; *(f32x4*)(dst + 4) = v1; }
            *(LAS u32x4*)(VGT + j * 72 + ch * 8) = pack8(v0, v1);
        }
    }
    __syncthreads();
    const int it = sample ? 0 : (wave >> 1), dt = wave & 1;
    const bool active = sample ? (wave < 2) : true;
    if (active) {
        const int i = 32 * it + r;
        const float bias = p.b_spatial[(l * 16 + g) * 128 + i];
        const int nks = 2 * (it + 1);
#pragma unroll
        for (int sub = 0; sub < 4; ++sub) {
            const int cidx = q * 4 + sub;
            const size_t row0 = sample ? (size_t)NP + cidx * 32 : (size_t)b * 2048 + cidx * 128;
            const LAS bf16_t* VGT = (const LAS bf16_t*)(lds + vgt_off(sub));
            const size_t row = row0 + i;
            const bf16_t* up = P + row * DPROJ + O_U + g * 64 + 32 * dt + 8 * h;
            const bf16_t* gp = P + row * DPROJ + O_GB + g * 64 + 32 * dt + 8 * h;
            u32x4 uw[2], gw[2];
#pragma unroll
            for (int pr = 0; pr < 2; ++pr) { uw[pr] = *(const u32x4*)(up + 16 * pr); gw[pr] = *(const u32x4*)(gp + 16 * pr); }
            f32x16 acc;
#pragma unroll
            for (int e = 0; e < 16; ++e) acc[e] = 0.f;
            const LAS bf16_t* tr = VGT + (8 * h + ((lane & 15) >> 2)) * 72 + 32 * dt + 16 * ((lane >> 4) & 1) + 4 * (lane & 3);
            for (int ks = 0; ks < nks; ++ks) {
                const s16x4 alo = __builtin_amdgcn_ds_read_tr16_b64_v4i16((LAS s16x4*)(tr + 16 * ks * 72)), ahi = __builtin_amdgcn_ds_read_tr16_b64_v4i16((LAS s16x4*)(tr + (16 * ks + 4) * 72));
                const bf16x8 a = __builtin_shufflevector(alo, ahi, 0, 1, 2, 3, 4, 5, 6, 7);
                const bf16x8 bw = *(const LAS bf16x8*)(WSL + (32 * it + r) * 136 + 16 * ks + 8 * h);
                acc = MFMA32(a, bw, acc);
            }
            bf16_t* yp = Y + row * DM + 1024 + g * 64 + 32 * dt + 8 * h;
            float ss = 0.f;
#pragma unroll
            for (int pr = 0; pr < 2; ++pr) {
                float a[4], bq[4];
#pragma unroll
                for (int k = 0; k < 4; ++k) { a[k] = acc[8 * pr + k] + bias; bq[k] = acc[8 * pr + 4 + k] + bias; }
#pragma unroll
                for (int k = 0; k < 4; ++k) swap_halves(a[k], bq[k]);
                const u32x4 u4 = uw[pr], g4 = gw[pr];
                a[0] *= bf_lo(u4.x); a[1] *= bf_hi(u4.x); a[2] *= bf_lo(u4.y); a[3] *= bf_hi(u4.y); bq[0] *= bf_lo(u4.z); bq[1] *= bf_hi(u4.z); bq[2] *= bf_lo(u4.w); bq[3] *= bf_hi(u4.w);
                ss += ((a[0] * a[0] + a[1] * a[1]) + (a[2] * a[2] + a[3] * a[3])) + ((bq[0] * bq[0] + bq[1] * bq[1]) + (bq[2] * bq[2] + bq[3] * bq[3]));
                u32x4 w; w.x = pk2(a[0] * bf_lo(g4.x), a[1] * bf_hi(g4.x)); w.y = pk2(a[2] * bf_lo(g4.y), a[3] * bf_hi(g4.y));
                w.z = pk2(bq[0] * bf_lo(g4.z), bq[1] * bf_hi(g4.z)); w.w = pk2(bq[2] * bf_lo(g4.w), bq[3] * bf_hi(g4.w));
                *(u32x4*)(yp + 16 * pr) = w;
            }
            ss += __shfl_xor(ss, 32);
            if (h == 0) ssb[row * 32 + g * 2 + dt] = ss;
        }
    }
    __syncthreads();
}

#define XB_TMO      128
#define XB_XCNT(j)  (256  + 64 * (j))
#define XB_XSUB(j)  (1280 + 64 * (j))
#define XB_XGEN(j)  (2304 + 64 * (j))
#define XB_TOP      3328
#define XB_TOPGEN   3392
#define XCD_BAR_WORDS 3456
#define XB_SPIN_CAP (1u << 18)

__device__ __forceinline__ unsigned xb_ld(unsigned* p)              { return __hip_atomic_load(p, __ATOMIC_RELAXED, __HIP_MEMORY_SCOPE_AGENT); }
__device__ __forceinline__ unsigned xb_add(unsigned* p, unsigned v) { return __hip_atomic_fetch_add(p, v, __ATOMIC_RELAXED, __HIP_MEMORY_SCOPE_AGENT); }
__device__ __forceinline__ unsigned xb_xcc_id() { return (unsigned)__builtin_amdgcn_s_getreg((3 << 11) | 20) & 0xFu; }
#define XB_SPIN(cond, bar) do { unsigned _sp = 0; while (cond) { __builtin_amdgcn_s_sleep(1); \
    if ((++_sp & 255u) == 0u) { if (xb_ld(&(bar)[XB_TMO])) break; if (_sp > XB_SPIN_CAP) { atomicAdd(&(bar)[XB_TMO], 1u); break; } } } } while (0)

struct XcdBarrier {
    unsigned* bar; unsigned x;
    volatile LAS unsigned* st;
};

__device__ __forceinline__ XcdBarrier xcd_barrier_post(unsigned* bar, volatile LAS unsigned* st) {
    XcdBarrier b; b.bar = bar; b.x = xb_xcc_id(); b.st = st;
    if (threadIdx.x == 0) (void)xb_add(&bar[XB_XCNT(b.x)], 1u);
    return b;
}
__device__ __forceinline__ void xcd_barrier_complete(unsigned* bar, unsigned x, unsigned& nloc, unsigned& nx) {
    const unsigned G = gridDim.x * gridDim.y * gridDim.z;
    unsigned sum, cnt, mine, sp = 0u;
    for (;;) {
        sum = 0u; cnt = 0u; mine = 0u;
#pragma unroll
        for (unsigned j = 0; j < 16; ++j) { const unsigned c = xb_ld(&bar[XB_XCNT(j)]); sum += c; cnt += (c > 0u) ? 1u : 0u; mine = (j == x) ? c : mine; }
        if (sum == G) break;
        __builtin_amdgcn_s_sleep(1);
        if ((++sp & 255u) == 0u) { if (xb_ld(&bar[XB_TMO])) break; if (sp > XB_SPIN_CAP) { atomicAdd(&bar[XB_TMO], 1u); break; } }
    }
    nloc = mine > 0u ? mine : 1u; nx = cnt > 0u ? cnt : 1u;
}

__device__ __forceinline__ void xcd_barrier(const XcdBarrier& b) {
    asm volatile("s_waitcnt vmcnt(0)" ::: "memory");
    __syncthreads();
    if (threadIdx.x == 0) {
        unsigned* bar = b.bar;
        __builtin_amdgcn_s_waitcnt(0);
        unsigned nloc = b.st[0], nx = b.st[1];
        if (nloc == 0u) { xcd_barrier_complete(bar, b.x, nloc, nx); b.st[0] = nloc; b.st[1] = nx; }
        const unsigned old = xb_add(&bar[XB_XSUB(b.x)], 1u);
        const unsigned gen = old / nloc;
        if (old + 1u == (gen + 1u) * nloc) {
            __builtin_amdgcn_fence(__ATOMIC_RELEASE, "agent");
            asm volatile("s_waitcnt vmcnt(0)" ::: "memory");
            const unsigned og = xb_add(&bar[XB_TOP], 1u);
            const unsigned tg = og / nx;
            if (og + 1u == (tg + 1u) * nx) xb_add(&bar[XB_TOPGEN], 1u);
            else XB_SPIN(xb_ld(&bar[XB_TOPGEN]) == tg, bar);
            __builtin_amdgcn_fence(__ATOMIC_ACQUIRE, "agent");
            xb_add(&bar[XB_XGEN(b.x)], 1u);
            asm volatile("s_waitcnt vmcnt(0)" ::: "memory");
        } else {
            XB_SPIN(xb_ld(&bar[XB_XGEN(b.x)]) == gen, bar);
            __builtin_amdgcn_fence(__ATOMIC_ACQUIRE, "agent");
            asm volatile("s_waitcnt vmcnt(0)" ::: "memory");
        }
    }
    __syncthreads();
}


struct OneUnit { int pm, pn; __device__ bool next(int i, pg8::Unit& u) const { if (i != 0) return false; u.pm = pm; u.pn = pn; return true; } };

template <class Sched>
__device__ __forceinline__ void run_in_proj(LAS unsigned char* lds, const Params& p, int l, const Sched& S, int M, int rows_off, int wave, int stage_off = -1) {
    unsigned char* ws = p.ws;
    const float* SSX = (const float*)(ws + WS_SSX);
    {
        const int ln = lane_fresh(), t = wave * 64 + ln, r = t >> 1, hf = t & 1;
        LAS float* rows = (LAS float*)(lds + rows_off); pg8::Unit u;
        for (int i = 0; i < 12 && S.next(i, u); ++i) {
            const f32x4* sp = (const f32x4*)(SSX + ((size_t)u.pm * 256 + r) * 32 + hf * 16);
            float sm = (sum4(sp[0]) + sum4(sp[1])) + (sum4(sp[2]) + sum4(sp[3]));
            sm += __shfl_xor(sm, 1);
            if (hf == 0) rows[i * 256 + r] = __builtin_amdgcn_rsqf(sm * (1.0f / 2048.0f) + EPS);
        }
        __syncthreads();
    }
    pg8::Gemm g{(const bf16_t*)(ws + WS_XB), (const bf16_t*)(ws + WS_WIN) + (size_t)l * DPROJ * DM, M, DPROJ, DM};
    EpiIn E{(bf16_t*)(ws + WS_P), (const LAS float*)(lds + rows_off), (float*)(ws + WS_SVG), p.out + OUT_KNP + (size_t)l * 524288, p.out + OUT_NVP + (size_t)l * 524288, p.out + OUT_NKS + (size_t)l * 1048576, p.out + OUT_NVS + (size_t)l * 1048576,
            stage_off >= 0 ? lds + stage_off : (LAS unsigned char*)nullptr};
    pg8::gemm_phase<EpiIn, Sched>(lds, g, S, E, wave);
}
template <class Sched>
__device__ __forceinline__ void run_out_proj(LAS unsigned char* lds, const Params& p, int l, const Sched& S, int M, int rows_off, int wave) {
    unsigned char* ws = p.ws;
    const float* SSA = (const float*)(ws + WS_SSA); const float* SSB = (const float*)(ws + WS_SSB);
    {
        const int ln = lane_fresh(), t = wave * 64 + ln, r = t >> 1, hf = t & 1;
        LAS float* rows = (LAS float*)(lds + rows_off); pg8::Unit u;
        for (int i = 0; i < 10 && S.next(i, u); ++i) {
            const size_t row = (size_t)u.pm * 256 + r;
            const f32x4* ap = (const f32x4*)(SSA + row * 16 + hf * 8); const f32x4* bp = (const f32x4*)(SSB + row * 32 + hf * 16);
            float sa = sum4(ap[0]) + sum4(ap[1]), sb = (sum4(bp[0]) + sum4(bp[1])) + (sum4(bp[2]) + sum4(bp[3]));
            sa += __shfl_xor(sa, 1); sb += __shfl_xor(sb, 1);
            const float a = sa * (1.0f / 1024.0f) + EPS, b = sb * (1.0f / 1024.0f) + EPS;
            if (hf == 0) { rows[i * 768 + r] = __builtin_sqrtf(a); rows[i * 768 + 256 + r] = __builtin_amdgcn_rsqf(a) * __builtin_sqrtf(b); rows[i * 768 + 512 + r] = __builtin_amdgcn_rsqf(b); }
        }
        __syncthreads();
    }
    pg8::Gemm g{(const bf16_t*)(ws + WS_Y), (const bf16_t*)(ws + WS_WOUT) + (size_t)l * DM * DM, M, DM, DM};
    EpiOut E{p.out, (bf16_t*)(ws + WS_XB), (float*)(ws + WS_SSX), (const LAS float*)(lds + rows_off), 0};
    pg8::gemm_phase<EpiOut, Sched>(lds, g, S, E, wave);
}

__device__ __forceinline__ void block_arrive(unsigned* cnt) {
    asm volatile("s_waitcnt vmcnt(0)" ::: "memory");
    __syncthreads();
    if (threadIdx.x == 0) { __builtin_amdgcn_fence(__ATOMIC_RELEASE, "agent"); asm volatile("s_waitcnt vmcnt(0)" ::: "memory"); (void)__hip_atomic_fetch_add(cnt, 1u, __ATOMIC_RELAXED, __HIP_MEMORY_SCOPE_AGENT); }
}
__device__ __forceinline__ void block_wait(unsigned* cnt, unsigned want) {
    if (threadIdx.x == 0) {
        unsigned spins = 0;
        while (__hip_atomic_load(cnt, __ATOMIC_RELAXED, __HIP_MEMORY_SCOPE_AGENT) < want) { __builtin_amdgcn_s_sleep(4); if (++spins > (1u << 24)) break; }
        __builtin_amdgcn_fence(__ATOMIC_ACQUIRE, "agent"); asm volatile("s_waitcnt vmcnt(0)" ::: "memory");
    }
    __syncthreads();
}

__device__ __forceinline__ void p2_phase(LAS unsigned char* lds, const Params& p, int l, int tid, int wave, int lane, int bid, int G) {
    lane = lane_fresh(); tid = wave * 64 + lane;
    unsigned char* ws = p.ws;
    const bf16_t* P = (const bf16_t*)(ws + WS_P); bf16_t* Y = (bf16_t*)(ws + WS_Y);
    const float* SVG = (const float*)(ws + WS_SVG); float* SSA = (float*)(ws + WS_SSA); float* SSB = (float*)(ws + WS_SSB);
    unsigned* CNT = (unsigned*)(ws + WS_CNT) + l * 512;
    LAS float* BIAS = (LAS float*)(lds + L_BIAS);
    for (int id = tid; id < 16 * 256; id += 512) {
        const int hh = id >> 8, idx = id & 255, rel = idx - 191, n = rel < 0 ? -rel : rel;
        int bk = n; if (n >= 8) { bk = 33 - __builtin_clz((unsigned)(n * n)); if (bk > 15) bk = 15; }
        bk += (rel > 0) ? 16 : 0;
        BIAS[id] = p.rel_bias[bk * 16 + hh] * LOG2E;
    }
    __syncthreads();
    if (bid < 128) attn_task(lds, p, P, Y, SSA, l, true, bid >> 2, 0, bid & 3, tid, wave, lane);
    else { const int u = bid - 128; gmlp_task(lds, p, P, Y, SVG, SSB, l, true, 0, u >> 3, u & 7, tid, wave, lane); }
    block_arrive(CNT);
    const int ngemm = (l < DEPTH - 1) ? 120 : 32;
    int start, count;
    if (bid < ngemm) { start = bid * 10; count = 10; }
    else { const int rest = 3072 - ngemm * 10, nb = 256 - ngemm, q = rest / nb, rem = rest - q * nb, j = bid - ngemm; start = ngemm * 10 + j * q + (j < rem ? j : rem); count = q + (j < rem ? 1 : 0); }
    const int end = start + count;
    const int ta0 = 2 * (start / 3) + (start % 3 < 2 ? start % 3 : 2), ta1 = 2 * (end / 3) + (end % 3 < 2 ? end % 3 : 2), ug0 = start / 3, ug1 = end / 3;
    const int tsplit = (bid < 32) ? (ta0 + 2 < ta1 ? ta0 + 2 : ta1) : ta1;
    attn_run(lds, p, P, Y, SSA, l, ta0, tsplit, wave);
    if (bid < 32) {
        block_wait(CNT, 256u);
        OneUnit S{128 + (bid >> 3), bid & 7};
        run_out_proj<OneUnit>(lds, p, l, S, MT, L_ROWS + 16384, wave);
        block_arrive(CNT + 64 * (1 + (bid >> 3)));
    }
    attn_run(lds, p, P, Y, SSA, l, tsplit, ta1, wave);
    for (int u = ug0; u < ug1; ++u)
        gmlp_task(lds, p, P, Y, SVG, SSB, l, false, (u >> 2) & 15, u >> 6, u & 3, tid, wave, lane, u == ug0 || (u >> 6) != ((u - 1) >> 6));
    if (bid >= 32 && bid < ngemm) {
        const int idx = bid - 32, tile = idx / 22;
        block_wait(CNT + 64 * (1 + tile), 8u);
        OneUnit S{128 + tile, idx - tile * 22};
        run_in_proj<OneUnit>(lds, p, l + 1, S, MT, L_ROWS + 16384, wave);
    }
}

__global__ void __launch_bounds__(512, 2) fwd_megakernel(Params p) {
    extern __shared__ __attribute__((aligned(16))) unsigned char lds_raw[];
    LAS unsigned char* lds = (LAS unsigned char*)lds_raw;
    cg::grid_group grid = cg::this_grid();
    const int wave = __builtin_amdgcn_readfirstlane(threadIdx.x >> 6), tid = 0, lane = 0, G = gridDim.x, bid = blockIdx.x;
    unsigned char* ws = p.ws;
    float* SSX = (float*)(ws + WS_SSX);

    {
        volatile LAS unsigned* st = (volatile LAS unsigned*)(lds + LDS_BYTES - 64);
        if (threadIdx.x < 2) st[threadIdx.x] = 0u;
        __syncthreads();
    }
    const XcdBarrier xbar = xcd_barrier_post((unsigned*)(ws + WS_CNT) + 4096, (volatile LAS unsigned*)(lds + LDS_BYTES - 64));
    prologue(lds, p, tid, wave, lane, bid, G);
    grid.sync();
#pragma unroll 1
    for (int l = 0; l < DEPTH; ++l) {
        {
            const int M = (l == 0) ? MT : NP;
            pg8::StaticOrder S; S.init(M, DPROJ, G, bid);
            run_in_proj<pg8::StaticOrder>(lds, p, l, S, M, L_ROWS, wave, L_ROWS + 12288);
        }
        xcd_barrier(xbar);
        p2_phase(lds, p, l, tid, wave, lane, bid, G);
        xcd_barrier(xbar);
        {
            pg8::StaticOrder S; S.init(NP, DM, G, bid);
            run_out_proj<pg8::StaticOrder>(lds, p, l, S, NP, L_ROWS, wave);
        }
        xcd_barrier(xbar);
    }
    {
        const int ll = lane_fresh();
        const int gw = bid * 8 + wave, NGW = G * 8;
        const f32x4* gf = (const f32x4*)p.norm_final + ll;
        const bf16_t* XBf = (const bf16_t*)(ws + WS_XB);
        f32x4 gv[8];
#pragma unroll
        for (int j = 0; j < 8; ++j) gv[j] = gf[64 * j];
        for (int row = gw; row < MT; row += 2 * NGW) {
            const int row2 = row + NGW; const bool two = row2 < MT; const int rb = two ? row2 : row;
            const u32x2* xa = (const u32x2*)(XBf + (size_t)row * DM) + ll; const u32x2* xb2 = (const u32x2*)(XBf + (size_t)rb * DM) + ll;
            u32x2 wa[8], wb[8];
#pragma unroll
            for (int j = 0; j < 8; ++j) wa[j] = xa[64 * j];
#pragma unroll
            for (int j = 0; j < 8; ++j) wb[j] = xb2[64 * j];
            const float pa = ll < 32 ? SSX[(size_t)row * 32 + ll] : 0.f, pb = ll < 32 ? SSX[(size_t)rb * 32 + ll] : 0.f;
            const float ra = __builtin_amdgcn_rsqf(wave_sum(pa) * (1.0f / 2048.0f) + EPS), rbs = __builtin_amdgcn_rsqf(wave_sum(pb) * (1.0f / 2048.0f) + EPS);
            f32x4* oa = (f32x4*)(p.out + (size_t)row * DM) + ll; f32x4* ob = (f32x4*)(p.out + (size_t)rb * DM) + ll;
#pragma unroll
            for (int j = 0; j < 8; ++j) { const u32x2 w = wa[j]; oa[64 * j] = (f32x4){bf_lo(w.x), bf_hi(w.x), bf_lo(w.y), bf_hi(w.y)} * ra * gv[j]; }
            if (two) {
#pragma unroll
                for (int j = 0; j < 8; ++j) { const u32x2 w = wb[j]; ob[64 * j] = (f32x4){bf_lo(w.x), bf_hi(w.x), bf_lo(w.y), bf_hi(w.y)} * rbs * gv[j]; }
            }
        }
    }
}

extern "C" void kernel_launch(void* const* d_in, const int* in_sizes, int n_in, void* d_out, int out_size, void* d_ws, size_t ws_size, hipStream_t stream) {
    static int grid = 0;
    if (grid == 0) {
        if (n_in != 16 || ws_size < WS_END) { fprintf(stderr, "kernel_launch: unexpected n_in %d / ws_size %zu\n", n_in, ws_size); grid = -1; return; }
        int dev = 0, cus = 0, per_cu = 0;
        hipGetDevice(&dev);
        hipDeviceGetAttribute(&cus, hipDeviceAttributeMultiprocessorCount, dev);
        hipFuncSetAttribute((const void*)fwd_megakernel, hipFuncAttributeMaxDynamicSharedMemorySize, LDS_BYTES);
        hipOccupancyMaxActiveBlocksPerMultiprocessor(&per_cu, (const void*)fwd_megakernel, 512, LDS_BYTES);
        if (per_cu < 1) per_cu = 1;
        (void)hipGetLastError();
        grid = cus * per_cu;
        if (grid != 256) { fprintf(stderr, "kernel_launch: this kernel's phase-2 schedule is built for a 256-workgroup grid, got %d\n", grid); grid = -1; return; }
    }
    if (grid < 0) return;
    Params p{};
    p.x_prompt = (const float*)d_in[0]; p.x_sample = (const float*)d_in[1]; p.cache_k = (const float*)d_in[2]; p.cache_v = (const float*)d_in[3];
    p.w_in = (const float*)d_in[4]; p.w_out = (const float*)d_in[5]; p.norm_in = (const float*)d_in[6]; p.rel_bias = (const float*)d_in[7]; p.sinks = (const float*)d_in[8];
    p.norm_attn = (const float*)d_in[9]; p.norm_gmlp = (const float*)d_in[10]; p.ln_v_g = (const float*)d_in[11]; p.ln_v_b = (const float*)d_in[12];
    p.w_spatial = (const float*)d_in[13]; p.b_spatial = (const float*)d_in[14]; p.norm_final = (const float*)d_in[15];
    p.out = (float*)d_out; p.ws = (unsigned char*)d_ws;
    (void)hipMemsetAsync((unsigned char*)d_ws + WS_CNT, 0, 65536, stream);
    void* args[] = {&p};
    hipError_t e = hipLaunchCooperativeKernel((const void*)fwd_megakernel, dim3(grid), dim3(512), args, LDS_BYTES, stream);
    if (e != hipSuccess) fprintf(stderr, "cooperative launch failed: %s (grid %d)\n", hipGetErrorString(e), grid);
}
```

```cpp
#include <hip/hip_runtime.h>
#include <hip/hip_cooperative_groups.h>
#include <cstdio>
#include <cstdint>
namespace cg = cooperative_groups;

#define LAS __attribute__((address_space(3)))
typedef unsigned short bf16_t;
typedef short bf16x8 __attribute__((ext_vector_type(8)));
typedef short s16x4 __attribute__((ext_vector_type(4)));
typedef float f32x4 __attribute__((ext_vector_type(4)));
typedef float f32x2 __attribute__((ext_vector_type(2)));
typedef float f32x16 __attribute__((ext_vector_type(16)));
typedef unsigned u32x4 __attribute__((ext_vector_type(4)));
typedef unsigned u32x2 __attribute__((ext_vector_type(2)));

constexpr int DM = 2048, NP = 16 * 2048, NS = 32 * 32, MT = NP + NS, DPROJ = 5632, DEPTH = 4;
constexpr int O_Q = 0, O_K = 1024, O_V = 1280, O_GA = 1536, O_U = 2560, O_VG = 3584, O_GB = 4608;
constexpr float EPS = 1e-6f, LOG2E = 1.4426950408889634f;
constexpr size_t OUT_KNP = (size_t)MT * DM, OUT_NVP = OUT_KNP + 2097152, OUT_NKS = OUT_NVP + 2097152, OUT_NVS = OUT_NKS + 4194304, OUT_VGS = OUT_NVS + 4194304;
constexpr size_t MiB = 1u << 20;
constexpr size_t WS_WIN = 0, WS_WOUT = 88 * MiB, WS_XB = 120 * MiB, WS_P = 252 * MiB, WS_Y = 616 * MiB, WS_SSX = 748 * MiB, WS_SVG = 753 * MiB, WS_SSA = 758 * MiB, WS_SSB = 761 * MiB, WS_CNT = 766 * MiB, WS_END = 767 * MiB;
static_assert((size_t)DEPTH * DPROJ * DM * 2 <= WS_WOUT && WS_WOUT + (size_t)DEPTH * DM * DM * 2 <= WS_XB && WS_XB + (size_t)MT * DM * 2 <= WS_P && WS_P + (size_t)MT * DPROJ * 2 <= WS_Y && WS_Y + (size_t)MT * DM * 2 <= WS_SSX, "ws map");
constexpr int LDS_BYTES = 163840, L_ROWS = 131072;

struct Params {
    const float *x_prompt, *x_sample, *cache_k, *cache_v, *w_in, *w_out, *norm_in, *rel_bias, *sinks, *norm_attn, *norm_gmlp, *ln_v_g, *ln_v_b, *w_spatial, *b_spatial, *norm_final;
    float* out; unsigned char* ws;
};

__device__ __forceinline__ unsigned f2bf(float f) { unsigned u = __builtin_bit_cast(unsigned, f); return (u + 0x7fffu + ((u >> 16) & 1u)) >> 16; }
typedef __bf16 bf16x2_t __attribute__((ext_vector_type(2)));
__device__ __forceinline__ unsigned pk2(float lo, float hi) { const f32x2 v = {lo, hi}; return __builtin_bit_cast(unsigned, __builtin_convertvector(v, bf16x2_t)); }
__device__ __forceinline__ float bf_lo(unsigned w) { return __builtin_bit_cast(float, w << 16); }
__device__ __forceinline__ float bf_hi(unsigned w) { return __builtin_bit_cast(float, w & 0xffff0000u); }
__device__ __forceinline__ float wave_sum(float v) {
#pragma unroll
    for (int o = 1; o < 64; o <<= 1) v += __shfl_xor(v, o);
    return v;
}
__device__ __forceinline__ int lane_fresh() { int l; asm volatile("v_mbcnt_lo_u32_b32 %0, -1, 0\n\tv_mbcnt_hi_u32_b32 %0, -1, %0" : "=v"(l)); return l; }
__device__ __forceinline__ void swap_halves(float& a, float& b) {
    const auto r = __builtin_amdgcn_permlane32_swap(__builtin_bit_cast(unsigned, a), __builtin_bit_cast(unsigned, b), false, false);
    unsigned x = r[0], y = r[1];
    asm volatile("" : "+v"(x), "+v"(y));
    a = __builtin_bit_cast(float, x); b = __builtin_bit_cast(float, y);
}
__device__ __forceinline__ float sum4(f32x4 v) { return (v[0] + v[1]) + (v[2] + v[3]); }
__device__ __forceinline__ float fq_sum(float v) { v += __shfl_xor(v, 16); v += __shfl_xor(v, 32); return v; }
__device__ __forceinline__ float silu_f(float v) { return v * __builtin_amdgcn_rcpf(1.0f + __builtin_amdgcn_exp2f(-v * LOG2E)); }
__device__ __forceinline__ f32x2 gelu_pk(f32x2 v) {
    f32x2 vc; vc.x = __builtin_amdgcn_fmed3f(v.x, -4.5f, 4.5f); vc.y = __builtin_amdgcn_fmed3f(v.y, -4.5f, 4.5f);
    const f32x2 t = vc * vc;
    f32x2 q = t * (-1.400032542e-12f) + 1.697268853e-10f;
    q = q * t + (-9.193600548e-09f); q = q * t + 2.958863661e-07f; q = q * t + (-6.365206445e-06f); q = q * t + 9.787092858e-05f;
    q = q * t + (-1.122676185e-03f); q = q * t + 9.833178483e-03f; q = q * t + (-6.633704901e-02f); q = q * t + 3.988837898e-01f;
    const f32x2 ph = vc * q + 0.5f;
    return v * ph;
}
__device__ __forceinline__ f32x4 gelu4(f32x4 v) { f32x2 a = gelu_pk((f32x2){v[0], v[1]}), b = gelu_pk((f32x2){v[2], v[3]}); return (f32x4){a.x, a.y, b.x, b.y}; }
__device__ __forceinline__ f32x4 silu4(f32x4 v) { return (f32x4){silu_f(v[0]), silu_f(v[1]), silu_f(v[2]), silu_f(v[3])}; }
__device__ __forceinline__ u32x4 pack8(f32x4 a, f32x4 b) { u32x4 w; w.x = pk2(a[0], a[1]); w.y = pk2(a[2], a[3]); w.z = pk2(b[0], b[1]); w.w = pk2(b[2], b[3]); return w; }

namespace pg8 {
constexpr int BM = 256, BK = 64, HALF = 128, HTB = HALF * BK * 2, STAGE_BYTES = 8 * HTB, NXCD = 8, WGM = 4;
__device__ __forceinline__ int lds_byte(int r, int c) { const int st = (r >> 4) * 2 + (c >> 5), rr = r & 15, cc = c & 31, ob = rr * 64 + cc * 2; return st * 1024 + (ob ^ (((ob >> 9) & 1) << 5)); }
__device__ __forceinline__ void stage_rc(int b, int& R, int& C) { const int st = b / 1024, sb = b % 1024, swz = sb ^ (((sb >> 9) & 1) << 5); R = (st >> 1) * 16 + swz / 64; C = (st & 1) * 32 + (swz % 64) / 2; }
__device__ __forceinline__ int perm32(int rho) { const int n = rho >> 4, i = rho & 15; return 8 * (i >> 2) + 4 * n + (i & 3); }
struct Unit { int pm, pn; };
struct Gemm { const bf16_t* A; const bf16_t* Bt; int M, N, K; };
struct StaticOrder {
    int nM, nN, nwg, G, c;
    __device__ void init(int M, int N, int G_, int c_) { nM = M / BM; nN = N / BM; nwg = nM * nN; G = G_; c = c_; }
    __device__ bool next(int i, Unit& u) const {
        const long L = (long)i * G + c; if (L >= nwg) return false;
        int wgid = (int)L; { const int q = nwg / NXCD, r = nwg % NXCD, xcd = wgid % NXCD, off = wgid / NXCD; wgid = (xcd < r ? xcd * (q + 1) : r * (q + 1) + (xcd - r) * q) + off; }
        const int nig = WGM * nN, gid = wgid / nig, fm = gid * WGM, gsz = (nM - fm) < WGM ? (nM - fm) : WGM;
        u.pm = fm + ((wgid % nig) % gsz); u.pn = (wgid % nig) / gsz; return true;
    }
};

template <class Epi, class Sched>
__device__ __forceinline__ void gemm_phase(LAS unsigned char* lds, const Gemm g, const Sched& S, const Epi& E, const int wid) {
    const int lane = lane_fresh(), tid = wid * 64 + lane, wr = wid >> 2, wc = wid & 3, fr = lane & 15, fq = lane >> 4;
    const int K = g.K, nt = K / BK;
    unsigned voffA[2], voffB[2];
#pragma unroll
    for (int i = 0; i < 2; ++i) { int R, C; stage_rc(tid * 16 + i * 8192, R, C); const int Rb = 2 * (R & ~31) + perm32(R & 31);
        voffA[i] = (unsigned)(R * K + C) * 2u; voffB[i] = (unsigned)(Rb * K + C) * 2u; }
    const size_t kstep = (size_t)(BK * 2);
    const size_t hstep = (size_t)HALF * K * 2;
    const size_t tstep = 2 * hstep;
    const size_t bstep = (size_t)32 * K * 2;
    const unsigned ldsw = (unsigned)wid * 1024u;
    const int aoff = lds_byte(wr * 64 + fr, fq * 8), boff = lds_byte(wc * 32 + fr, fq * 8);
#define PG8_SA(b, h) (((b) * 2 + (h)) * HTB)
#define PG8_SB(b, h) ((4 + (b) * 2 + (h)) * HTB)
#define PG8_STAGE(bufoff, gbase, voff) do { _Pragma("unroll") for (int _i = 0; _i < 2; ++_i) \
        __builtin_amdgcn_global_load_lds((const unsigned*)((const char*)(gbase) + (voff)[_i]), (LAS unsigned*)(lds + (bufoff) + ldsw + _i * 8192), 16, 0, 0); } while (0)
#define PG8_LDA(dst, b, h) do { _Pragma("unroll") for (int m = 0; m < 4; ++m) _Pragma("unroll") for (int k = 0; k < 2; ++k) dst[m][k] = *(const LAS bf16x8*)(lds + PG8_SA(b, h) + aoff + m * 2048 + k * 1024); } while (0)
#define PG8_LDB(dst, b, h) do { _Pragma("unroll") for (int n = 0; n < 2; ++n) _Pragma("unroll") for (int k = 0; k < 2; ++k) dst[n][k] = *(const LAS bf16x8*)(lds + PG8_SB(b, h) + boff + n * 2048 + k * 1024); } while (0)
#define PG8_MMA(ai, bj, At, Bt) do { __builtin_amdgcn_s_setprio(1); _Pragma("unroll") for (int m = 0; m < 4; ++m) _Pragma("unroll") for (int n = 0; n < 2; ++n) _Pragma("unroll") for (int k = 0; k < 2; ++k) \
        acc[ai][bj][m][n] = __builtin_amdgcn_mfma_f32_16x16x32_bf16(Bt[n][k], At[m][k], acc[ai][bj][m][n], 0, 0, 0); __builtin_amdgcn_s_setprio(0); } while (0)
#define PG8_WAIT_V(n) asm volatile("s_waitcnt vmcnt(" #n ")" ::: "memory")
#define PG8_WAIT_L(n) asm volatile("s_waitcnt lgkmcnt(" #n ")" ::: "memory")
#define PG8_BAR __builtin_amdgcn_s_barrier()
#define PG8_SCHED __builtin_amdgcn_sched_barrier(0)
    Unit cur, nxt; int ui = 0;
    if (!S.next(0, cur)) return;
    f32x4 acc[2][2][4][2];
    if constexpr (Epi::INIT) E.init(acc, cur, 0, wr, wc, fr, fq);
    else {
#pragma unroll
    for (int a = 0; a < 2; ++a)
#pragma unroll
        for (int b = 0; b < 2; ++b)
#pragma unroll
            for (int m = 0; m < 4; ++m)
#pragma unroll
                for (int n = 0; n < 2; ++n) acc[a][b][m][n] = (f32x4){0.f, 0.f, 0.f, 0.f};
    }
    bf16x8 At[4][2], B0[2][2], B1[2][2];
    const char* cA = (const char*)g.A + (size_t)cur.pm * tstep; const char* cB = (const char*)g.Bt + (size_t)cur.pn * tstep;
    PG8_STAGE(PG8_SB(0, 0), cB, voffB); PG8_STAGE(PG8_SB(0, 1), cB + bstep, voffB); PG8_STAGE(PG8_SA(0, 0), cA, voffA); PG8_STAGE(PG8_SA(0, 1), cA + hstep, voffA);
    if (wr == 1) PG8_BAR;
    PG8_WAIT_V(2); PG8_BAR;
    PG8_STAGE(PG8_SB(1, 0), cB + kstep, voffB); PG8_STAGE(PG8_SA(1, 0), cA + kstep, voffA); PG8_STAGE(PG8_SB(1, 1), cB + bstep + kstep, voffB);
    PG8_WAIT_V(6); PG8_BAR;
    for (;;) {
        const bool has_next = S.next(ui + 1, nxt);
        const char* nA = has_next ? (const char*)g.A + (size_t)nxt.pm * tstep : cA; const char* nB = has_next ? (const char*)g.Bt + (size_t)nxt.pn * tstep : cB;
        for (int t = 0; t < nt; t += 2) {
            const bool last = (t == nt - 2);
            const char* a1 = cA + (size_t)(t + 1) * kstep;
            const char* a2 = last ? nA : cA + (size_t)(t + 2) * kstep; const char* b2 = last ? nB : cB + (size_t)(t + 2) * kstep;
            const char* a3 = a2 + kstep; const char* b3 = b2 + kstep;
            if constexpr (Epi::MID) { if (t == nt / 2) E.mid(acc, cur, ui, wr, wc, fr, fq); }
            PG8_LDB(B0, 0, 0); PG8_LDB(B1, 0, 1); PG8_SCHED; PG8_LDA(At, 0, 0); PG8_STAGE(PG8_SA(1, 1), a1 + hstep, voffA);
            PG8_WAIT_V(8); PG8_WAIT_L(0); PG8_BAR; PG8_MMA(0, 0, At, B0); PG8_MMA(0, 1, At, B1); PG8_BAR; PG8_SCHED;
            PG8_LDA(At, 0, 1); PG8_STAGE(PG8_SB(0, 0), b2, voffB); PG8_STAGE(PG8_SB(0, 1), b2 + bstep, voffB); PG8_STAGE(PG8_SA(0, 0), a2, voffA);
            PG8_WAIT_V(8); PG8_WAIT_L(0); PG8_BAR; PG8_MMA(1, 0, At, B0); PG8_MMA(1, 1, At, B1); PG8_BAR; PG8_SCHED;
            PG8_LDB(B0, 1, 0); PG8_LDB(B1, 1, 1); PG8_SCHED; PG8_LDA(At, 1, 0); PG8_STAGE(PG8_SA(0, 1), a2 + hstep, voffA);
            PG8_WAIT_V(8); PG8_WAIT_L(0); PG8_BAR; PG8_MMA(0, 0, At, B0); PG8_MMA(0, 1, At, B1); PG8_BAR; PG8_SCHED;
            PG8_LDA(At, 1, 1); PG8_STAGE(PG8_SB(1, 0), b3, voffB); PG8_STAGE(PG8_SB(1, 1), b3 + bstep, voffB); PG8_STAGE(PG8_SA(1, 0), a3, voffA);
            PG8_WAIT_V(8); PG8_WAIT_L(0); PG8_BAR; PG8_MMA(1, 0, At, B0); PG8_MMA(1, 1, At, B1); PG8_BAR; PG8_SCHED;
        }
        if (wr == 0) PG8_BAR;
        E(acc, cur, ui, wr, wc, fr, fq);
        if (!has_next) break;
        if constexpr (Epi::INIT) E.init(acc, nxt, ui + 1, wr, wc, fr, fq);
        else {
#pragma unroll
        for (int a = 0; a < 2; ++a)
#pragma unroll
            for (int b = 0; b < 2; ++b)
#pragma unroll
                for (int m = 0; m < 4; ++m)
#pragma unroll
                    for (int n = 0; n < 2; ++n) acc[a][b][m][n] = (f32x4){0.f, 0.f, 0.f, 0.f};
        }
        cur = nxt; cA = nA; cB = nB; ++ui;
        if (wr == 1) PG8_BAR;
    }
    PG8_WAIT_V(0);
    PG8_BAR;
#undef PG8_SA
#undef PG8_SB
#undef PG8_STAGE
#undef PG8_LDA
#undef PG8_LDB
#undef PG8_MMA
#undef PG8_WAIT_V
#undef PG8_WAIT_L
#undef PG8_BAR
#undef PG8_SCHED
}
}

struct EpiIn {
    static constexpr bool MID = false, INIT = false;
    bf16_t* P; const LAS float* rows; float* svg; float* knp; float* nvp; float* nks; float* nvs; LAS unsigned char* stg;
    template <int KIND>
    __device__ __forceinline__ void body(const f32x4 (&acc)[2][2][4][2], const pg8::Unit& u, int ui, int wr, int wc, int fr, int fq) const {
        const int row0 = u.pm * 256 + wr * 64 + fr;
        const int col0 = u.pn * 256 + wc * 64 + 8 * fq;
        const LAS float* rsl = rows + ui * 256 + wr * 64 + fr;
        const int sl = fq * 16 + fr, srow = sl >> 3, spc = sl & 7;
        LAS unsigned char* sw = stg ? stg + (wr * 4 + wc) * 2304 : nullptr;
#pragma unroll
        for (int ai = 0; ai < 2; ++ai)
#pragma unroll
            for (int m = 0; m < 4; ++m) {
                const int row = row0 + ai * 128 + m * 16;
                const float rs = rsl[ai * 128 + m * 16];
                bf16_t* rowp = P + (size_t)row * DPROJ + col0;
                float* dst = nullptr;
                if (KIND == 4) {
                    float* bp = (u.pn == 5) ? nvp : knp; float* bs = (u.pn == 5) ? nvs : nks;
                    if (u.pm < 128) { if ((u.pm & 7) == 7 && ai == 1) dst = bp + (size_t)((u.pm >> 3) * 128 + wr * 64 + m * 16 + fr) * 256 + wc * 64 + 8 * fq; }
                    else { const int sr = row - NP; dst = bs + (size_t)((sr >> 5) * 128 + 96 + (sr & 31)) * 256 + wc * 64 + 8 * fq; }
                }
                float s1 = 0.f, s2 = 0.f;
#pragma unroll
                for (int bj = 0; bj < 2; ++bj) {
                    f32x4 v0 = acc[ai][bj][m][0] * rs, v1 = acc[ai][bj][m][1] * rs;
                    if (KIND == 1) { v0 = silu4(v0); v1 = silu4(v1); }
                    if (KIND == 2 || KIND == 3) { v0 = gelu4(v0); v1 = gelu4(v1); }
                    if (KIND == 3) { s1 += (v0[0] + v0[1]) + (v0[2] + v0[3]) + (v1[0] + v1[1]) + (v1[2] + v1[3]);
                        s2 += (v0[0] * v0[0] + v0[1] * v0[1]) + (v0[2] * v0[2] + v0[3] * v0[3]) + (v1[0] * v1[0] + v1[1] * v1[1]) + (v1[2] * v1[2] + v1[3] * v1[3]); }
                    if (sw) *(LAS u32x4*)(sw + fr * 144 + bj * 64 + fq * 16) = pack8(v0, v1);
                    else *(u32x4*)(rowp + bj * 32) = pack8(v0, v1);
                    if (KIND == 4) { if (dst) { *(f32x4*)(dst + bj * 32) = v0; *(f32x4*)(dst + bj * 32 + 4) = v1; } }
                }
                if (sw) {
                    bf16_t* gb = P + (size_t)(u.pm * 256 + ai * 128 + wr * 64 + m * 16 + srow) * DPROJ + u.pn * 256 + wc * 64 + spc * 8;
                    const u32x4 w0 = *(const LAS u32x4*)(sw + srow * 144 + spc * 16), w1 = *(const LAS u32x4*)(sw + (srow + 8) * 144 + spc * 16);
                    *(u32x4*)gb = w0; *(u32x4*)(gb + (size_t)8 * DPROJ) = w1;
                }
                if (KIND == 3) {
                    s1 = fq_sum(s1); s2 = fq_sum(s2);
                    if (fq == 0) *(f32x2*)(svg + ((size_t)row * 16 + (u.pn - 14) * 4 + wc) * 2) = (f32x2){s1, s2};
                }
            }
    }
    __device__ __forceinline__ void operator()(const f32x4 (&acc)[2][2][4][2], const pg8::Unit& u, int ui, int wr, int wc, int fr, int fq) const {
        const int pn = u.pn;
        if (pn < 4) body<0>(acc, u, ui, wr, wc, fr, fq);
        else if (pn < 6) body<4>(acc, u, ui, wr, wc, fr, fq);
        else if (pn < 10 || pn >= 18) body<1>(acc, u, ui, wr, wc, fr, fq);
        else if (pn < 14) body<2>(acc, u, ui, wr, wc, fr, fq);
        else body<3>(acc, u, ui, wr, wc, fr, fq);
    }
};

struct EpiOut {
    static constexpr bool MID = true, INIT = true;
    float* out; bf16_t* xb; float* ssx; const LAS float* rows; int last;
    __device__ __forceinline__ void init(f32x4 (&acc)[2][2][4][2], const pg8::Unit& u, int ui, int wr, int wc, int fr, int fq) const {
        int row0 = u.pm * 256 + wr * 64 + fr;
        asm volatile("" : "+v"(row0));
        const int col0 = u.pn * 256 + wc * 64 + 8 * fq;
        const LAS float* rl = rows + ui * 768 + ((row0 - u.pm * 256));
#pragma unroll
        for (int ai = 0; ai < 2; ++ai)
#pragma unroll
            for (int m = 0; m < 4; ++m) {
                const int row = row0 + ai * 128 + m * 16;
                const bf16_t* base = xb + (size_t)row * DM + col0;
#pragma unroll
                for (int bj = 0; bj < 2; ++bj) { const u32x4 w = *(const u32x4*)(base + bj * 32);
                    acc[ai][bj][m][0] = (f32x4){bf_lo(w.x), bf_hi(w.x), bf_lo(w.y), bf_hi(w.y)}; acc[ai][bj][m][1] = (f32x4){bf_lo(w.z), bf_hi(w.z), bf_lo(w.w), bf_hi(w.w)}; }
            }
#pragma unroll
        for (int ai = 0; ai < 2; ++ai)
#pragma unroll
            for (int m = 0; m < 4; ++m) {
                const float ia = rl[ai * 128 + m * 16];
#pragma unroll
                for (int bj = 0; bj < 2; ++bj)
#pragma unroll
                    for (int n = 0; n < 2; ++n) acc[ai][bj][m][n] = acc[ai][bj][m][n] * ia;
            }
    }
    __device__ __forceinline__ void mid(f32x4 (&acc)[2][2][4][2], const pg8::Unit& u, int ui, int wr, int wc, int fr, int fq) const {
        int rt = wr * 64 + fr;
        asm volatile("" : "+v"(rt));
        const LAS float* rl = rows + ui * 768 + 256 + rt;
#pragma unroll
        for (int ai = 0; ai < 2; ++ai)
#pragma unroll
            for (int m = 0; m < 4; ++m) {
                const float ratio = rl[ai * 128 + m * 16];
#pragma unroll
                for (int bj = 0; bj < 2; ++bj)
#pragma unroll
                    for (int n = 0; n < 2; ++n) acc[ai][bj][m][n] = acc[ai][bj][m][n] * ratio;
            }
    }
    __device__ __forceinline__ void operator()(const f32x4 (&acc)[2][2][4][2], const pg8::Unit& u, int ui, int wr, int wc, int fr, int fq) const {
        const int row0 = u.pm * 256 + wr * 64 + fr;
        const int col0 = u.pn * 256 + wc * 64 + 8 * fq;
        const LAS float* rl = rows + ui * 768 + 512 + wr * 64 + fr;
#pragma unroll
        for (int ai = 0; ai < 2; ++ai)
#pragma unroll
            for (int m = 0; m < 4; ++m) {
                const int row = row0 + ai * 128 + m * 16;
                const float rb = rl[ai * 128 + m * 16];
                float* o = out + (size_t)row * DM + col0; bf16_t* xo = xb + (size_t)row * DM + col0;
                float ss = 0.f;
#pragma unroll
                for (int bj = 0; bj < 2; ++bj) {
                    const f32x4 v0 = acc[ai][bj][m][0] * rb, v1 = acc[ai][bj][m][1] * rb;
                    if (last) { *(f32x4*)(o + bj * 32) = v0; *(f32x4*)(o + bj * 32 + 4) = v1; }
                    else *(u32x4*)(xo + bj * 32) = pack8(v0, v1);
                    ss += (v0[0] * v0[0] + v0[1] * v0[1]) + (v0[2] * v0[2] + v0[3] * v0[3]) + (v1[0] * v1[0] + v1[1] * v1[1]) + (v1[2] * v1[2] + v1[3] * v1[3]);
                }
                ss = fq_sum(ss);
                if (fq == 0) ssx[(size_t)row * 32 + u.pn * 4 + wc] = ss;
            }
    }
};

struct TItem { const float* W; const float* gk; bf16_t* WT; int N, k0, n0; };
__device__ __forceinline__ TItem p0_item(const Params& p, bf16_t* WIN, bf16_t* WOUT, int it) {
    constexpr int I_IN = (DM / 64) * (DPROJ / 32), I_OUT = (DM / 64) * (DM / 32), I_L = I_IN + I_OUT;
    const int l = it / I_L; int r = it - l * I_L; TItem t;
    if (r < I_IN) { const int nblk = DPROJ / 32, kb = r / nblk; t.k0 = 64 * kb; t.n0 = 32 * (r - kb * nblk); t.N = DPROJ; t.W = p.w_in + (size_t)l * DM * DPROJ; t.gk = p.norm_in + l * DM + t.k0; t.WT = WIN + (size_t)l * DPROJ * DM; }
    else { r -= I_IN; const int nblk = DM / 32, kb = r / nblk; t.k0 = 64 * kb; t.n0 = 32 * (r - kb * nblk); t.N = DM; t.W = p.w_out + (size_t)l * DM * DM;
        t.gk = (t.k0 < 1024) ? p.norm_attn + l * 1024 + t.k0 : p.norm_gmlp + l * 1024 + (t.k0 - 1024); t.WT = WOUT + (size_t)l * DM * DM; }
    return t;
}
__device__ __forceinline__ void p0_load(const TItem& t, f32x4 (&v)[8], int lane) {
#pragma unroll
    for (int i = 0; i < 8; ++i) { const int kk = 8 * i + (lane >> 3); v[i] = *(const f32x4*)(t.W + (size_t)(t.k0 + kk) * t.N + t.n0 + 4 * (lane & 7)) * t.gk[kk]; }
}
__device__ __forceinline__ void p0_emit(const TItem& t, const f32x4 (&v)[8], LAS float* scr, int lane) {
#pragma unroll
    for (int i = 0; i < 8; ++i) { LAS float* d = scr + (8 * i + (lane >> 3)) * 33 + 4 * (lane & 7); d[0] = v[i][0]; d[1] = v[i][1]; d[2] = v[i][2]; d[3] = v[i][3]; }
    asm volatile("s_waitcnt lgkmcnt(0)" ::: "memory");
    const int c = lane & 7;
#pragma unroll
    for (int j = 0; j < 4; ++j) { const int n = (lane >> 3) + 8 * j; const LAS float* sp = scr + (8 * c) * 33 + n;
        u32x4 o; o.x = pk2(sp[0 * 33], sp[1 * 33]); o.y = pk2(sp[2 * 33], sp[3 * 33]); o.z = pk2(sp[4 * 33], sp[5 * 33]); o.w = pk2(sp[6 * 33], sp[7 * 33]);
        *(u32x4*)(t.WT + (size_t)(t.n0 + n) * DM + t.k0 + 8 * c) = o; }
    asm volatile("s_waitcnt lgkmcnt(0)" ::: "memory");
}

__device__ __forceinline__ void prologue(LAS unsigned char* lds, const Params& p, int tid, int wave, int lane, int bid, int G) {
    lane = lane_fresh(); tid = wave * 64 + lane;
    unsigned char* ws = p.ws;
    bf16_t* WIN = (bf16_t*)(ws + WS_WIN); bf16_t* WOUT = (bf16_t*)(ws + WS_WOUT); bf16_t* XB = (bf16_t*)(ws + WS_XB);
    float* SSX = (float*)(ws + WS_SSX);
    LAS float* scr = (LAS float*)(lds + wave * 17408);
    const int gw = bid * 8 + wave, NGW = G * 8;
    constexpr int NIT = DEPTH * ((DM / 64) * (DPROJ / 32) + (DM / 64) * (DM / 32));
    for (int it = gw; it < NIT; it += 2 * NGW) {
        const bool two = it + NGW < NIT;
        const TItem ta = p0_item(p, WIN, WOUT, it), tb = p0_item(p, WIN, WOUT, two ? it + NGW : it);
        f32x4 va[8], vb[8];
        p0_load(ta, va, lane); if (two) p0_load(tb, vb, lane);
        p0_emit(ta, va, scr, lane); if (two) p0_emit(tb, vb, scr + 64 * 33, lane);
    }
    for (int row = gw; row < MT; row += 2 * NGW) {
        const int row2 = row + NGW; const bool two = row2 < MT; const int rb = two ? row2 : row;
        const f32x4* xa = (const f32x4*)(row < NP ? p.x_prompt + (size_t)row * DM : p.x_sample + (size_t)(row - NP) * DM) + lane;
        const f32x4* xb2 = (const f32x4*)(rb < NP ? p.x_prompt + (size_t)rb * DM : p.x_sample + (size_t)(rb - NP) * DM) + lane;
        f32x4 va[8], vb[8];
#pragma unroll
        for (int j = 0; j < 8; ++j) va[j] = xa[64 * j];
#pragma unroll
        for (int j = 0; j < 8; ++j) vb[j] = xb2[64 * j];
        u32x2* oa = (u32x2*)(XB + (size_t)row * DM) + lane; u32x2* ob = (u32x2*)(XB + (size_t)rb * DM) + lane;
        float sa = 0.f, sb = 0.f;
#pragma unroll
        for (int j = 0; j < 8; ++j) { const f32x4 v = va[j]; sa += (v[0] * v[0] + v[1] * v[1]) + (v[2] * v[2] + v[3] * v[3]); u32x2 w; w.x = pk2(v[0], v[1]); w.y = pk2(v[2], v[3]); oa[64 * j] = w; }
        if (two) {
#pragma unroll
            for (int j = 0; j < 8; ++j) { const f32x4 v = vb[j]; sb += (v[0] * v[0] + v[1] * v[1]) + (v[2] * v[2] + v[3] * v[3]); u32x2 w; w.x = pk2(v[0], v[1]); w.y = pk2(v[2], v[3]); ob[64 * j] = w; }
        }
        sa = wave_sum(sa); sb = wave_sum(sb);
        if (lane < 32) { SSX[(size_t)row * 32 + lane] = (lane == 0) ? sa : 0.f; if (two) SSX[(size_t)row2 * 32 + lane] = (lane == 0) ? sb : 0.f; }
    }
    for (int seg = bid; seg < 256; seg += G) {
        const int kv = seg >> 7, lb = seg & 127;
        const f32x4* src = (const f32x4*)((kv ? p.cache_v : p.cache_k) + ((size_t)lb * 128 + 32) * 256);
        f32x4* dst = (f32x4*)(p.out + (kv ? OUT_NVS : OUT_NKS) + (size_t)lb * 128 * 256);
        for (int i = tid; i < 96 * 64; i += 512) dst[i] = src[i];
    }
}

constexpr int L_KS = 0, L_VT = 27648, L_WS = 73728, L_MUR = 108544, L_BIAS = 131072;
#define MFMA32(a, b, c) __builtin_amdgcn_mfma_f32_32x32x16_bf16((a), (b), (c), 0, 0, 0)
__device__ __forceinline__ bf16x8 pack_step(const f32x16& x, int s) {
    u32x4 w; w.x = pk2(x[8 * s], x[8 * s + 1]); w.y = pk2(x[8 * s + 2], x[8 * s + 3]); w.z = pk2(x[8 * s + 4], x[8 * s + 5]); w.w = pk2(x[8 * s + 6], x[8 * s + 7]);
    return __builtin_bit_cast(bf16x8, w);
}

__device__ __forceinline__ void attn_task(LAS unsigned char* lds, const Params& p, const bf16_t* P, bf16_t* Y, float* ssa, int l, bool sample, int b, int c, int kvh, int tid, int wave, int lane) {
    lane = lane_fresh(); tid = wave * 64 + lane;
    LAS bf16_t* KS = (LAS bf16_t*)(lds + L_KS);
    LAS bf16_t* VT = (LAS bf16_t*)(lds + L_VT);
    const LAS float* BIAS = (const LAS float*)(lds + L_BIAS);
    const int nk = sample ? 160 : 192;
    const int jmin = sample ? 0 : (c >= 2 ? 0 : (2 - c) * 64);
    for (int id = tid; id < nk * 8; id += 512) {
        const int j = id >> 3, ch = id & 7;
        if (j >= jmin) {
            u32x4 w;
            if (sample && j < 128) { const float* src = p.cache_k + ((((size_t)l * 32 + b) * 128 + j) * 4 + kvh) * 64 + ch * 8; w = pack8(*(const f32x4*)src, *(const f32x4*)(src + 4)); }
            else { const size_t row = sample ? (size_t)NP + b * 32 + (j - 128) : (size_t)b * 2048 + (c - 2) * 64 + j; w = *(const u32x4*)(P + row * DPROJ + O_K + kvh * 64 + ch * 8); }
            *(LAS u32x4*)(KS + j * 72 + ch * 8) = w;
        }
    }
    for (int id = tid; id < nk * 8; id += 512) {
        const int ch = id / nk, j = id - ch * nk;
        if (j >= jmin) {
            u32x4 w;
            if (sample && j < 128) { const float* src = p.cache_v + ((((size_t)l * 32 + b) * 128 + j) * 4 + kvh) * 64 + ch * 8; w = pack8(*(const f32x4*)src, *(const f32x4*)(src + 4)); }
            else { const size_t row = sample ? (size_t)NP + b * 32 + (j - 128) : (size_t)b * 2048 + (c - 2) * 64 + j; w = *(const u32x4*)(P + row * DPROJ + O_V + kvh * 64 + ch * 8); }
#pragma unroll
            for (int e = 0; e < 4; ++e) { VT[(ch * 8 + 2 * e) * 200 + j] = (bf16_t)(w[e] & 0xffffu); VT[(ch * 8 + 2 * e + 1) * 200 + j] = (bf16_t)(w[e] >> 16); }
        }
    }
    __syncthreads();
    const int r = lane & 31, h = lane >> 5;
    const bool active = sample ? (wave < 4) : true;
    if (active) {
        const int g = sample ? wave : (wave >> 1), qh = sample ? 0 : (wave & 1);
        const int head = kvh * 4 + g, i = 32 * qh + r;
        const size_t qrow = sample ? (size_t)NP + b * 32 + i : (size_t)b * 2048 + c * 64 + i;
        bf16x8 qf[4];
#pragma unroll
        for (int s = 0; s < 4; ++s) qf[s] = *(const bf16x8*)(P + qrow * DPROJ + O_Q + head * 64 + 16 * s + 8 * h);
        const bf16_t* gp = P + qrow * DPROJ + O_GA + head * 64 + 8 * h;
        u32x4 gwv[4];
#pragma unroll
        for (int e = 0; e < 4; ++e) gwv[e] = *(const u32x4*)(gp + 16 * e);
        const int T0 = jmin >> 5, NT = nk >> 5;
        f32x16 st[6];
#pragma unroll
        for (int T = 0; T < 6; ++T) {
            f32x16 acc;
            if (T >= T0 && T < NT) {
#pragma unroll
                for (int e = 0; e < 16; ++e) acc[e] = 0.f;
#pragma unroll
                for (int s = 0; s < 4; ++s) { const bf16x8 a = *(const LAS bf16x8*)(KS + (32 * T + r) * 72 + 16 * s + 8 * h); acc = MFMA32(a, qf[s], acc); }
            } else {
#pragma unroll
                for (int e = 0; e < 16; ++e) acc[e] = -1e30f;
            }
            st[T] = acc;
        }
        const float sc = 0.125f * LOG2E;
        const LAS float* bl = BIAS + head * 256 + 63 - i + 4 * h;
        float mx = -3e38f;
#pragma unroll
        for (int T = 0; T < 6; ++T)
            if (T >= T0 && T < NT) {
#pragma unroll
                for (int e = 0; e < 16; ++e) { const float v = st[T][e] * sc + bl[32 * T + (e & 3) + 8 * (e >> 2)]; st[T][e] = v; mx = fmaxf(mx, v); }
                }
        mx = fmaxf(mx, __shfl_xor(mx, 32));
        const float sink2 = p.sinks[l * 16 + head] * LOG2E;
        mx = fmaxf(mx, sink2);
        float sum = 0.f;
#pragma unroll
        for (int T = 0; T < 6; ++T)
#pragma unroll
            for (int e = 0; e < 16; ++e) { const float pv = __builtin_amdgcn_exp2f(st[T][e] - mx); st[T][e] = pv; sum += pv; }
        sum += __shfl_xor(sum, 32);
        sum += __builtin_amdgcn_exp2f(sink2 - mx);
        const float inv = 1.0f / sum;
        f32x16 o[2];
#pragma unroll
        for (int e = 0; e < 16; ++e) { o[0][e] = 0.f; o[1][e] = 0.f; }
#pragma unroll
        for (int T = 0; T < 6; ++T)
            if (T >= T0 && T < NT) {
#pragma unroll
                for (int s = 0; s < 2; ++s) {
                    const bf16x8 xs = pack_step(st[T], s);
#pragma unroll
                    for (int dt = 0; dt < 2; ++dt) {
                        const LAS bf16_t* vp = VT + (32 * dt + r) * 200 + 32 * T + 16 * s + 4 * h;
                        const s16x4 lo = *(const LAS s16x4*)vp, hi = *(const LAS s16x4*)(vp + 8);
                        const bf16x8 pa = __builtin_shufflevector(lo, hi, 0, 1, 2, 3, 4, 5, 6, 7);
                        o[dt] = MFMA32(pa, xs, o[dt]);
                    }
                }
                }
        float ss = 0.f;
        bf16_t* yp = Y + qrow * DM + head * 64 + 8 * h;
#pragma unroll
        for (int dt = 0; dt < 2; ++dt)
#pragma unroll
            for (int pr = 0; pr < 2; ++pr) {
                float a[4], bq[4];
#pragma unroll
                for (int k = 0; k < 4; ++k) { a[k] = o[dt][8 * pr + k] * inv; bq[k] = o[dt][8 * pr + 4 + k] * inv; }
                ss += ((a[0] * a[0] + a[1] * a[1]) + (a[2] * a[2] + a[3] * a[3])) + ((bq[0] * bq[0] + bq[1] * bq[1]) + (bq[2] * bq[2] + bq[3] * bq[3]));
#pragma unroll
                for (int k = 0; k < 4; ++k) swap_halves(a[k], bq[k]);
                const u32x4 gw = gwv[2 * dt + pr];
                u32x4 w; w.x = pk2(a[0] * bf_lo(gw.x), a[1] * bf_hi(gw.x)); w.y = pk2(a[2] * bf_lo(gw.y), a[3] * bf_hi(gw.y));
                w.z = pk2(bq[0] * bf_lo(gw.z), bq[1] * bf_hi(gw.z)); w.w = pk2(bq[2] * bf_lo(gw.w), bq[3] * bf_hi(gw.w));
                *(u32x4*)(yp + 32 * dt + 16 * pr) = w;
            }
        ss += __shfl_xor(ss, 32);
        if (h == 0) ssa[qrow * 16 + head] = ss;
    }
    __syncthreads();
}

__device__ __forceinline__ void attn_run(LAS unsigned char* lds, const Params& p, const bf16_t* P, bf16_t* Y, float* ssa, int l, int t0, int t1, int wave) {
    if (t0 >= t1) return;
    const int lane = lane_fresh(), tid = wave * 64 + lane;
    LAS bf16_t* KS = (LAS bf16_t*)(lds + L_KS);
    LAS bf16_t* VT = (LAS bf16_t*)(lds + L_VT);
    const LAS float* BIAS = (const LAS float*)(lds + L_BIAS);
    const int r = lane & 31, h = lane >> 5;
    const int jk = tid >> 3, chk = tid & 7;
    const int jv = jk, chv = chk;
    u32x4 pk = (u32x4){0u, 0u, 0u, 0u}, pv = pk;
    bf16x8 qn[4];
#pragma unroll
    for (int s = 0; s < 4; ++s) qn[s] = (bf16x8){0, 0, 0, 0, 0, 0, 0, 0};
    int prev_bk = -1, prev_c = -100;
    for (int t = t0; t < t1; ++t) {
        const int c = t & 31, bk = t >> 5, kvh = bk & 3, b = bk >> 2;
        const bool cont = (bk == prev_bk) && (c == prev_c + 1);
        const bf16_t* Pk = P + ((size_t)b * 2048 + jk) * DPROJ + O_K + kvh * 64 + chk * 8;
        const bf16_t* Pv = P + ((size_t)b * 2048 + jv) * DPROJ + O_V + kvh * 64 + chv * 8;
        if (cont) {
            const int slot = c % 3;
            *(LAS u32x4*)(KS + (slot * 64 + jk) * 72 + chk * 8) = pk;
            *(LAS u32x4*)(VT + (slot * 64 + jv) * 72 + chv * 8) = pv;
        } else {
            for (int q = (c >= 2 ? c - 2 : 0); q <= c; ++q) {
                const int slot = q % 3;
                const u32x4 wk = *(const u32x4*)(Pk + (size_t)q * 64 * DPROJ), wv = *(const u32x4*)(Pv + (size_t)q * 64 * DPROJ);
                *(LAS u32x4*)(KS + (slot * 64 + jk) * 72 + chk * 8) = wk;
                *(LAS u32x4*)(VT + (slot * 64 + jv) * 72 + chv * 8) = wv;
            }
        }
        __syncthreads();
        {
            const int g = wave >> 1, qh = wave & 1;
            const int head = kvh * 4 + g, i = 32 * qh + r;
            const size_t qrow = (size_t)b * 2048 + c * 64 + i;
            const bf16_t* qp = P + qrow * DPROJ + O_Q + head * 64 + 8 * h;
            bf16x8 qf[4];
            if (cont) {
#pragma unroll
                for (int s = 0; s < 4; ++s) qf[s] = qn[s];
            } else {
#pragma unroll
                for (int s = 0; s < 4; ++s) qf[s] = *(const bf16x8*)(qp + 16 * s);
            }
            if (t + 1 < t1 && ((t + 1) >> 5) == bk) {
                pk = *(const u32x4*)(Pk + (size_t)(c + 1) * 64 * DPROJ); pv = *(const u32x4*)(Pv + (size_t)(c + 1) * 64 * DPROJ);
#pragma unroll
                for (int s = 0; s < 4; ++s) qn[s] = *(const bf16x8*)(qp + (size_t)64 * DPROJ + 16 * s);
            }
            const bf16_t* gp = P + qrow * DPROJ + O_GA + head * 64 + 8 * h;
            u32x4 gwv[4];
#pragma unroll
            for (int e = 0; e < 4; ++e) gwv[e] = *(const u32x4*)(gp + 16 * e);
            const int T0 = c >= 2 ? 0 : 2 * (2 - c);
            const int sl0 = (c + 1) % 3, sl1 = (c + 2) % 3, sl2 = c % 3;
            f32x16 st[6];
#pragma unroll
            for (int T = 0; T < 6; ++T) {
                f32x16 acc;
                const int prow = 64 * ((T >> 1) == 0 ? sl0 : ((T >> 1) == 1 ? sl1 : sl2)) + 32 * (T & 1);
                if (T >= T0) {
#pragma unroll
                    for (int e = 0; e < 16; ++e) acc[e] = 0.f;
#pragma unroll
                    for (int s = 0; s < 4; ++s) { const bf16x8 a = *(const LAS bf16x8*)(KS + (prow + r) * 72 + 16 * s + 8 * h); acc = MFMA32(a, qf[s], acc); }
                } else {
#pragma unroll
                    for (int e = 0; e < 16; ++e) acc[e] = -1e30f;
                }
                st[T] = acc;
            }
            const float sc = 0.125f * LOG2E;
            const LAS float* bl = BIAS + head * 256 + 63 - i + 4 * h;
            float mx = -3e38f;
#pragma unroll
            for (int T = 0; T < 6; ++T)
                if (T >= T0) {
#pragma unroll
                    for (int e = 0; e < 16; ++e) { const float v = st[T][e] * sc + bl[32 * T + (e & 3) + 8 * (e >> 2)]; st[T][e] = v; mx = fmaxf(mx, v); }
                }
            mx = fmaxf(mx, __shfl_xor(mx, 32));
            const float sink2 = p.sinks[l * 16 + head] * LOG2E;
            mx = fmaxf(mx, sink2);
            float sum = 0.f;
#pragma unroll
            for (int T = 0; T < 6; ++T)
#pragma unroll
                for (int e = 0; e < 16; ++e) { const float pe = __builtin_amdgcn_exp2f(st[T][e] - mx); st[T][e] = pe; sum += pe; }
            sum += __shfl_xor(sum, 32);
            sum += __builtin_amdgcn_exp2f(sink2 - mx);
            const float inv = 1.0f / sum;
            f32x16 o[2];
#pragma unroll
            for (int e = 0; e < 16; ++e) { o[0][e] = 0.f; o[1][e] = 0.f; }
#pragma unroll
            for (int T = 0; T < 6; ++T)
                if (T >= T0) {
                    const int prow = 64 * ((T >> 1) == 0 ? sl0 : ((T >> 1) == 1 ? sl1 : sl2)) + 32 * (T & 1);
#pragma unroll
                    for (int s = 0; s < 2; ++s) {
                        const bf16x8 xs = pack_step(st[T], s);
#pragma unroll
                        for (int dt = 0; dt < 2; ++dt) {
                            const LAS bf16_t* vp = VT + (prow + 16 * s + 4 * h + ((lane & 15) >> 2)) * 72 + 32 * dt + 16 * ((lane >> 4) & 1) + 4 * (lane & 3);
                            const s16x4 lo = __builtin_amdgcn_ds_read_tr16_b64_v4i16((LAS s16x4*)vp), hi = __builtin_amdgcn_ds_read_tr16_b64_v4i16((LAS s16x4*)(vp + 8 * 72));
                            const bf16x8 pa = __builtin_shufflevector(lo, hi, 0, 1, 2, 3, 4, 5, 6, 7);
                            o[dt] = MFMA32(pa, xs, o[dt]);
                        }
                    }
                }
            float ss = 0.f;
            bf16_t* yp = Y + qrow * DM + head * 64 + 8 * h;
#pragma unroll
            for (int dt = 0; dt < 2; ++dt)
#pragma unroll
                for (int pr = 0; pr < 2; ++pr) {
                    float a[4], bq[4];
#pragma unroll
                    for (int k = 0; k < 4; ++k) { a[k] = o[dt][8 * pr + k] * inv; bq[k] = o[dt][8 * pr + 4 + k] * inv; }
                    ss += ((a[0] * a[0] + a[1] * a[1]) + (a[2] * a[2] + a[3] * a[3])) + ((bq[0] * bq[0] + bq[1] * bq[1]) + (bq[2] * bq[2] + bq[3] * bq[3]));
#pragma unroll
                    for (int k = 0; k < 4; ++k) swap_halves(a[k], bq[k]);
                    const u32x4 gw = gwv[2 * dt + pr];
                    u32x4 w; w.x = pk2(a[0] * bf_lo(gw.x), a[1] * bf_hi(gw.x)); w.y = pk2(a[2] * bf_lo(gw.y), a[3] * bf_hi(gw.y));
                    w.z = pk2(bq[0] * bf_lo(gw.z), bq[1] * bf_hi(gw.z)); w.w = pk2(bq[2] * bf_lo(gw.w), bq[3] * bf_hi(gw.w));
                    *(u32x4*)(yp + 32 * dt + 16 * pr) = w;
                }
            ss += __shfl_xor(ss, 32);
            if (h == 0) ssa[qrow * 16 + head] = ss;
        }
        __syncthreads();
        prev_bk = bk; prev_c = c;
    }
}

__device__ __forceinline__ int vgt_off(int sidx) { return sidx * 18432; }
__device__ __forceinline__ void gmlp_task(LAS unsigned char* lds, const Params& p, const bf16_t* P, bf16_t* Y, const float* svg, float* ssb, int l, bool sample, int b, int g, int q, int tid, int wave, int lane, bool load_ws = true) {
    lane = lane_fresh(); tid = wave * 64 + lane;
    LAS bf16_t* WSL = (LAS bf16_t*)(lds + L_WS);
    LAS f32x2* MUR = (LAS f32x2*)(lds + L_MUR);
    if (load_ws) {
        const float* wsp = p.w_spatial + (size_t)(l * 16 + g) * 128 * 128;
#pragma unroll
        for (int k = 0; k < 4; ++k) {
            const int id = tid + 512 * k, i = id >> 4, j0 = (id & 15) * 8;
            f32x4 a = *(const f32x4*)(wsp + i * 128 + j0), bb = *(const f32x4*)(wsp + i * 128 + j0 + 4);
#pragma unroll
            for (int e = 0; e < 4; ++e) { if (j0 + e > i) a[e] = 0.f; if (j0 + 4 + e > i) bb[e] = 0.f; }
            *(LAS u32x4*)(WSL + i * 136 + j0) = pack8(a, bb);
        }
    }
    const int L = sample ? 32 : 128;
    const int r = lane & 31, h = lane >> 5;
    const float* lg = p.ln_v_g + l * 1024 + g * 64; const float* lb = p.ln_v_b + l * 1024 + g * 64;
    u32x4 wraw[4][2];
#pragma unroll
    for (int sub = 0; sub < 4; ++sub) {
        const int cidx = q * 4 + sub;
        const size_t row0 = sample ? (size_t)NP + cidx * 32 : (size_t)b * 2048 + cidx * 128;
#pragma unroll
        for (int k = 0; k < 2; ++k) {
            const int id = tid + 512 * k;
            if (id < L * 8) { const int ch = id & 7, j = id >> 3; wraw[sub][k] = *(const u32x4*)(P + (row0 + j) * DPROJ + O_VG + g * 64 + ch * 8); }
            else wraw[sub][k] = (u32x4){0u, 0u, 0u, 0u};
        }
    }
#pragma unroll
    for (int sub = 0; sub < 4; ++sub) {
        const int cidx = q * 4 + sub;
        const size_t row0 = sample ? (size_t)NP + cidx * 32 : (size_t)b * 2048 + cidx * 128;
        if ((tid >> 2) < L) {
            const int j = tid >> 2, qq = tid & 3;
            const f32x4* sp = (const f32x4*)(svg + ((row0 + j) * 16 + qq * 4) * 2);
            const f32x4 a = sp[0], bq = sp[1];
            float s1 = (a[0] + a[2]) + (bq[0] + bq[2]), s2 = (a[1] + a[3]) + (bq[1] + bq[3]);
            s1 += __shfl_xor(s1, 1); s1 += __shfl_xor(s1, 2); s2 += __shfl_xor(s2, 1); s2 += __shfl_xor(s2, 2);
            const float mean = s1 * (1.0f / 1024.0f), var = s2 * (1.0f / 1024.0f) - mean * mean;
            if (qq == 0) MUR[sub * 128 + j] = (f32x2){mean, __builtin_amdgcn_rsqf(var + EPS)};
        }
    }
    __syncthreads();
#pragma unroll
    for (int sub = 0; sub < 4; ++sub) {
        const int cidx = q * 4 + sub;
        const size_t row0 = sample ? (size_t)NP + cidx * 32 : (size_t)b * 2048 + cidx * 128;
        LAS bf16_t* VGT = (LAS bf16_t*)(lds + vgt_off(sub));
#pragma unroll
        for (int k = 0; k < 2; ++k) {
            const int id = tid + 512 * k;
            if (id >= L * 8) continue;
            const int ch = id & 7, j = id >> 3;
            const f32x2 mr = MUR[sub * 128 + j];
            const float mean = mr.x, rstd = mr.y;
            const u32x4 w = wraw[sub][k];
            const f32x4 g0 = *(const f32x4*)(lg + ch * 8), g1 = *(const f32x4*)(lg + ch * 8 + 4), b0 = *(const f32x4*)(lb + ch * 8), b1 = *(const f32x4*)(lb + ch * 8 + 4);
            f32x4 v0 = (f32x4){bf_lo(w.x), bf_hi(w.x), bf_lo(w.y), bf_hi(w.y)}, v1 = (f32x4){bf_lo(w.z), bf_hi(w.z), bf_lo(w.w), bf_hi(w.w)};
            v0 = (v0 - mean) * rstd * g0 + b0; v1 = (v1 - mean) * rstd * g1 + b1;
            if (sample) { float* dst = p.out + OUT_VGS + ((((size_t)l * 32 + cidx) * 32 + j) * 16 + g) * 64 + ch * 8; *(f32x4*)dst = v0; *(f32x4*)(dst + 4) = v1; }
            *(LAS u32x4*)(VGT + j * 72 + ch * 8) = pack8(v0, v1);
        }
    }
    __syncthreads();
    const int it = sample ? 0 : (wave >> 1), dt = wave & 1;
    const bool active = sample ? (wave < 2) : true;
    if (active) {
        const int i = 32 * it + r;
        const float bias = p.b_spatial[(l * 16 + g) * 128 + i];
        const int nks = 2 * (it + 1);
#pragma unroll
        for (int sub = 0; sub < 4; ++sub) {
            const int cidx = q * 4 + sub;
            const size_t row0 = sample ? (size_t)NP + cidx * 32 : (size_t)b * 2048 + cidx * 128;
            const LAS bf16_t* VGT = (const LAS bf16_t*)(lds + vgt_off(sub));
            const size_t row = row0 + i;
            const bf16_t* up = P + row * DPROJ + O_U + g * 64 + 32 * dt + 8 * h;
            const bf16_t* gp = P + row * DPROJ + O_GB + g * 64 + 32 * dt + 8 * h;
            u32x4 uw[2], gw[2];
#pragma unroll
            for (int pr = 0; pr < 2; ++pr) { uw[pr] = *(const u32x4*)(up + 16 * pr); gw[pr] = *(const u32x4*)(gp + 16 * pr); }
            f32x16 acc;
#pragma unroll
            for (int e = 0; e < 16; ++e) acc[e] = 0.f;
            const LAS bf16_t* tr = VGT + (8 * h + ((lane & 15) >> 2)) * 72 + 32 * dt + 16 * ((lane >> 4) & 1) + 4 * (lane & 3);
            for (int ks = 0; ks < nks; ++ks) {
                const s16x4 alo = __builtin_amdgcn_ds_read_tr16_b64_v4i16((LAS s16x4*)(tr + 16 * ks * 72)), ahi = __builtin_amdgcn_ds_read_tr16_b64_v4i16((LAS s16x4*)(tr + (16 * ks + 4) * 72));
                const bf16x8 a = __builtin_shufflevector(alo, ahi, 0, 1, 2, 3, 4, 5, 6, 7);
                const bf16x8 bw = *(const LAS bf16x8*)(WSL + (32 * it + r) * 136 + 16 * ks + 8 * h);
                acc = MFMA32(a, bw, acc);
            }
            bf16_t* yp = Y + row * DM + 1024 + g * 64 + 32 * dt + 8 * h;
            float ss = 0.f;
#pragma unroll
            for (int pr = 0; pr < 2; ++pr) {
                float a[4], bq[4];
#pragma unroll
                for (int k = 0; k < 4; ++k) { a[k] = acc[8 * pr + k] + bias; bq[k] = acc[8 * pr + 4 + k] + bias; }
#pragma unroll
                for (int k = 0; k < 4; ++k) swap_halves(a[k], bq[k]);
                const u32x4 u4 = uw[pr], g4 = gw[pr];
                a[0] *= bf_lo(u4.x); a[1] *= bf_hi(u4.x); a[2] *= bf_lo(u4.y); a[3] *= bf_hi(u4.y); bq[0] *= bf_lo(u4.z); bq[1] *= bf_hi(u4.z); bq[2] *= bf_lo(u4.w); bq[3] *= bf_hi(u4.w);
                ss += ((a[0] * a[0] + a[1] * a[1]) + (a[2] * a[2] + a[3] * a[3])) + ((bq[0] * bq[0] + bq[1] * bq[1]) + (bq[2] * bq[2] + bq[3] * bq[3]));
                u32x4 w; w.x = pk2(a[0] * bf_lo(g4.x), a[1] * bf_hi(g4.x)); w.y = pk2(a[2] * bf_lo(g4.y), a[3] * bf_hi(g4.y));
                w.z = pk2(bq[0] * bf_lo(g4.z), bq[1] * bf_hi(g4.z)); w.w = pk2(bq[2] * bf_lo(g4.w), bq[3] * bf_hi(g4.w));
                *(u32x4*)(yp + 16 * pr) = w;
            }
            ss += __shfl_xor(ss, 32);
            if (h == 0) ssb[row * 32 + g * 2 + dt] = ss;
        }
    }
    __syncthreads();
}

#define XB_TMO      128
#define XB_XCNT(j)  (256  + 64 * (j))
#define XB_XSUB(j)  (1280 + 64 * (j))
#define XB_XGEN(j)  (2304 + 64 * (j))
#define XB_TOP      3328
#define XB_TOPGEN   3392
#define XCD_BAR_WORDS 3456
#define XB_SPIN_CAP (1u << 18)

__device__ __forceinline__ unsigned xb_ld(unsigned* p)              { return __hip_atomic_load(p, __ATOMIC_RELAXED, __HIP_MEMORY_SCOPE_AGENT); }
__device__ __forceinline__ unsigned xb_add(unsigned* p, unsigned v) { return __hip_atomic_fetch_add(p, v, __ATOMIC_RELAXED, __HIP_MEMORY_SCOPE_AGENT); }
__device__ __forceinline__ unsigned xb_xcc_id() { return (unsigned)__builtin_amdgcn_s_getreg((3 << 11) | 20) & 0xFu; }
#define XB_SPIN(cond, bar) do { unsigned _sp = 0; while (cond) { __builtin_amdgcn_s_sleep(1); \
    if ((++_sp & 255u) == 0u) { if (xb_ld(&(bar)[XB_TMO])) break; if (_sp > XB_SPIN_CAP) { atomicAdd(&(bar)[XB_TMO], 1u); break; } } } } while (0)

struct XcdBarrier {
    unsigned* bar; unsigned x;
    volatile LAS unsigned* st;
};

__device__ __forceinline__ XcdBarrier xcd_barrier_post(unsigned* bar, volatile LAS unsigned* st) {
    XcdBarrier b; b.bar = bar; b.x = xb_xcc_id(); b.st = st;
    if (threadIdx.x == 0) (void)xb_add(&bar[XB_XCNT(b.x)], 1u);
    return b;
}
__device__ __forceinline__ void xcd_barrier_complete(unsigned* bar, unsigned x, unsigned& nloc, unsigned& nx) {
    const unsigned G = gridDim.x * gridDim.y * gridDim.z;
    unsigned sum, cnt, mine, sp = 0u;
    for (;;) {
        sum = 0u; cnt = 0u; mine = 0u;
#pragma unroll
        for (unsigned j = 0; j < 16; ++j) { const unsigned c = xb_ld(&bar[XB_XCNT(j)]); sum += c; cnt += (c > 0u) ? 1u : 0u; mine = (j == x) ? c : mine; }
        if (sum == G) break;
        __builtin_amdgcn_s_sleep(1);
        if ((++sp & 255u) == 0u) { if (xb_ld(&bar[XB_TMO])) break; if (sp > XB_SPIN_CAP) { atomicAdd(&bar[XB_TMO], 1u); break; } }
    }
    nloc = mine > 0u ? mine : 1u; nx = cnt > 0u ? cnt : 1u;
}

__device__ __forceinline__ void xcd_barrier(const XcdBarrier& b) {
    asm volatile("s_waitcnt vmcnt(0)" ::: "memory");
    __syncthreads();
    if (threadIdx.x == 0) {
        unsigned* bar = b.bar;
        __builtin_amdgcn_s_waitcnt(0);
        unsigned nloc = b.st[0], nx = b.st[1];
        if (nloc == 0u) { xcd_barrier_complete(bar, b.x, nloc, nx); b.st[0] = nloc; b.st[1] = nx; }
        const unsigned old = xb_add(&bar[XB_XSUB(b.x)], 1u);
        const unsigned gen = old / nloc;
        if (old + 1u == (gen + 1u) * nloc) {
            __builtin_amdgcn_fence(__ATOMIC_RELEASE, "agent");
            asm volatile("s_waitcnt vmcnt(0)" ::: "memory");
            const unsigned og = xb_add(&bar[XB_TOP], 1u);
            const unsigned tg = og / nx;
            if (og + 1u == (tg + 1u) * nx) xb_add(&bar[XB_TOPGEN], 1u);
            else XB_SPIN(xb_ld(&bar[XB_TOPGEN]) == tg, bar);
            __builtin_amdgcn_fence(__ATOMIC_ACQUIRE, "agent");
            xb_add(&bar[XB_XGEN(b.x)], 1u);
            asm volatile("s_waitcnt vmcnt(0)" ::: "memory");
        } else {
            XB_SPIN(xb_ld(&bar[XB_XGEN(b.x)]) == gen, bar);
            __builtin_amdgcn_fence(__ATOMIC_ACQUIRE, "agent");
            asm volatile("s_waitcnt vmcnt(0)" ::: "memory");
        }
    }
    __syncthreads();
}


struct OneUnit { int pm, pn; __device__ bool next(int i, pg8::Unit& u) const { if (i != 0) return false; u.pm = pm; u.pn = pn; return true; } };

template <class Sched>
__device__ __forceinline__ void run_in_proj(LAS unsigned char* lds, const Params& p, int l, const Sched& S, int M, int rows_off, int wave, int stage_off = -1) {
    unsigned char* ws = p.ws;
    const float* SSX = (const float*)(ws + WS_SSX);
    {
        const int ln = lane_fresh(), t = wave * 64 + ln, r = t >> 1, hf = t & 1;
        LAS float* rows = (LAS float*)(lds + rows_off); pg8::Unit u;
        for (int i = 0; i < 12 && S.next(i, u); ++i) {
            const f32x4* sp = (const f32x4*)(SSX + ((size_t)u.pm * 256 + r) * 32 + hf * 16);
            float sm = (sum4(sp[0]) + sum4(sp[1])) + (sum4(sp[2]) + sum4(sp[3]));
            sm += __shfl_xor(sm, 1);
            if (hf == 0) rows[i * 256 + r] = __builtin_amdgcn_rsqf(sm * (1.0f / 2048.0f) + EPS);
        }
        __syncthreads();
    }
    pg8::Gemm g{(const bf16_t*)(ws + WS_XB), (const bf16_t*)(ws + WS_WIN) + (size_t)l * DPROJ * DM, M, DPROJ, DM};
    EpiIn E{(bf16_t*)(ws + WS_P), (const LAS float*)(lds + rows_off), (float*)(ws + WS_SVG), p.out + OUT_KNP + (size_t)l * 524288, p.out + OUT_NVP + (size_t)l * 524288, p.out + OUT_NKS + (size_t)l * 1048576, p.out + OUT_NVS + (size_t)l * 1048576,
            stage_off >= 0 ? lds + stage_off : (LAS unsigned char*)nullptr};
    pg8::gemm_phase<EpiIn, Sched>(lds, g, S, E, wave);
}
template <class Sched>
__device__ __forceinline__ void run_out_proj(LAS unsigned char* lds, const Params& p, int l, const Sched& S, int M, int rows_off, int wave) {
    unsigned char* ws = p.ws;
    const float* SSA = (const float*)(ws + WS_SSA); const float* SSB = (const float*)(ws + WS_SSB);
    {
        const int ln = lane_fresh(), t = wave * 64 + ln, r = t >> 1, hf = t & 1;
        LAS float* rows = (LAS float*)(lds + rows_off); pg8::Unit u;
        for (int i = 0; i < 10 && S.next(i, u); ++i) {
            const size_t row = (size_t)u.pm * 256 + r;
            const f32x4* ap = (const f32x4*)(SSA + row * 16 + hf * 8); const f32x4* bp = (const f32x4*)(SSB + row * 32 + hf * 16);
            float sa = sum4(ap[0]) + sum4(ap[1]), sb = (sum4(bp[0]) + sum4(bp[1])) + (sum4(bp[2]) + sum4(bp[3]));
            sa += __shfl_xor(sa, 1); sb += __shfl_xor(sb, 1);
            const float a = sa * (1.0f / 1024.0f) + EPS, b = sb * (1.0f / 1024.0f) + EPS;
            if (hf == 0) { rows[i * 768 + r] = __builtin_sqrtf(a); rows[i * 768 + 256 + r] = __builtin_amdgcn_rsqf(a) * __builtin_sqrtf(b); rows[i * 768 + 512 + r] = __builtin_amdgcn_rsqf(b); }
        }
        __syncthreads();
    }
    pg8::Gemm g{(const bf16_t*)(ws + WS_Y), (const bf16_t*)(ws + WS_WOUT) + (size_t)l * DM * DM, M, DM, DM};
    EpiOut E{p.out, (bf16_t*)(ws + WS_XB), (float*)(ws + WS_SSX), (const LAS float*)(lds + rows_off), 0};
    pg8::gemm_phase<EpiOut, Sched>(lds, g, S, E, wave);
}

__device__ __forceinline__ void block_arrive(unsigned* cnt) {
    asm volatile("s_waitcnt vmcnt(0)" ::: "memory");
    __syncthreads();
    if (threadIdx.x == 0) { __builtin_amdgcn_fence(__ATOMIC_RELEASE, "agent"); asm volatile("s_waitcnt vmcnt(0)" ::: "memory"); (void)__hip_atomic_fetch_add(cnt, 1u, __ATOMIC_RELAXED, __HIP_MEMORY_SCOPE_AGENT); }
}
__device__ __forceinline__ void block_wait(unsigned* cnt, unsigned want) {
    if (threadIdx.x == 0) {
        unsigned spins = 0;
        while (__hip_atomic_load(cnt, __ATOMIC_RELAXED, __HIP_MEMORY_SCOPE_AGENT) < want) { __builtin_amdgcn_s_sleep(4); if (++spins > (1u << 24)) break; }
        __builtin_amdgcn_fence(__ATOMIC_ACQUIRE, "agent"); asm volatile("s_waitcnt vmcnt(0)" ::: "memory");
    }
    __syncthreads();
}

__device__ __forceinline__ void p2_phase(LAS unsigned char* lds, const Params& p, int l, int tid, int wave, int lane, int bid, int G) {
    lane = lane_fresh(); tid = wave * 64 + lane;
    unsigned char* ws = p.ws;
    const bf16_t* P = (const bf16_t*)(ws + WS_P); bf16_t* Y = (bf16_t*)(ws + WS_Y);
    const float* SVG = (const float*)(ws + WS_SVG); float* SSA = (float*)(ws + WS_SSA); float* SSB = (float*)(ws + WS_SSB);
    unsigned* CNT = (unsigned*)(ws + WS_CNT) + l * 512;
    LAS float* BIAS = (LAS float*)(lds + L_BIAS);
    for (int id = tid; id < 16 * 256; id += 512) {
        const int hh = id >> 8, idx = id & 255, rel = idx - 191, n = rel < 0 ? -rel : rel;
        int bk = n; if (n >= 8) { bk = 33 - __builtin_clz((unsigned)(n * n)); if (bk > 15) bk = 15; }
        bk += (rel > 0) ? 16 : 0;
        BIAS[id] = p.rel_bias[bk * 16 + hh] * LOG2E;
    }
    __syncthreads();
    if (bid < 128) attn_task(lds, p, P, Y, SSA, l, true, bid >> 2, 0, bid & 3, tid, wave, lane);
    else { const int u = bid - 128; gmlp_task(lds, p, P, Y, SVG, SSB, l, true, 0, u >> 3, u & 7, tid, wave, lane); }
    block_arrive(CNT);
    const int ngemm = (l < DEPTH - 1) ? 120 : 32;
    int start, count;
    if (bid < ngemm) { start = bid * 10; count = 10; }
    else { const int rest = 3072 - ngemm * 10, nb = 256 - ngemm, q = rest / nb, rem = rest - q * nb, j = bid - ngemm; start = ngemm * 10 + j * q + (j < rem ? j : rem); count = q + (j < rem ? 1 : 0); }
    const int end = start + count;
    const int ta0 = 2 * (start / 3) + (start % 3 < 2 ? start % 3 : 2), ta1 = 2 * (end / 3) + (end % 3 < 2 ? end % 3 : 2), ug0 = start / 3, ug1 = end / 3;
    const int tsplit = (bid < 32) ? (ta0 + 2 < ta1 ? ta0 + 2 : ta1) : ta1;
    attn_run(lds, p, P, Y, SSA, l, ta0, tsplit, wave);
    if (bid < 32) {
        block_wait(CNT, 256u);
        OneUnit S{128 + (bid >> 3), bid & 7};
        run_out_proj<OneUnit>(lds, p, l, S, MT, L_ROWS + 16384, wave);
        block_arrive(CNT + 64 * (1 + (bid >> 3)));
    }
    attn_run(lds, p, P, Y, SSA, l, tsplit, ta1, wave);
    for (int u = ug0; u < ug1; ++u)
        gmlp_task(lds, p, P, Y, SVG, SSB, l, false, (u >> 2) & 15, u >> 6, u & 3, tid, wave, lane, u == ug0 || (u >> 6) != ((u - 1) >> 6));
    if (bid >= 32 && bid < ngemm) {
        const int idx = bid - 32, tile = idx / 22;
        block_wait(CNT + 64 * (1 + tile), 8u);
        OneUnit S{128 + tile, idx - tile * 22};
        run_in_proj<OneUnit>(lds, p, l + 1, S, MT, L_ROWS + 16384, wave);
    }
}

__global__ void __launch_bounds__(512, 2) fwd_megakernel(Params p) {
    extern __shared__ __attribute__((aligned(16))) unsigned char lds_raw[];
    LAS unsigned char* lds = (LAS unsigned char*)lds_raw;
    cg::grid_group grid = cg::this_grid();
    const int wave = __builtin_amdgcn_readfirstlane(threadIdx.x >> 6), tid = 0, lane = 0, G = gridDim.x, bid = blockIdx.x;
    unsigned char* ws = p.ws;
    float* SSX = (float*)(ws + WS_SSX);

    {
        volatile LAS unsigned* st = (volatile LAS unsigned*)(lds + LDS_BYTES - 64);
        if (threadIdx.x < 2) st[threadIdx.x] = 0u;
        __syncthreads();
    }
    const XcdBarrier xbar = xcd_barrier_post((unsigned*)(ws + WS_CNT) + 4096, (volatile LAS unsigned*)(lds + LDS_BYTES - 64));
    prologue(lds, p, tid, wave, lane, bid, G);
    grid.sync();
#pragma unroll 1
    for (int l = 0; l < DEPTH; ++l) {
        {
            const int M = (l == 0) ? MT : NP;
            pg8::StaticOrder S; S.init(M, DPROJ, G, bid);
            run_in_proj<pg8::StaticOrder>(lds, p, l, S, M, L_ROWS, wave, L_ROWS + 12288);
        }
        xcd_barrier(xbar);
        p2_phase(lds, p, l, tid, wave, lane, bid, G);
        xcd_barrier(xbar);
        {
            pg8::StaticOrder S; S.init(NP, DM, G, bid);
            run_out_proj<pg8::StaticOrder>(lds, p, l, S, NP, L_ROWS, wave);
        }
        xcd_barrier(xbar);
    }
    {
        const int ll = lane_fresh();
        const int gw = bid * 8 + wave, NGW = G * 8;
        const f32x4* gf = (const f32x4*)p.norm_final + ll;
        const bf16_t* XBf = (const bf16_t*)(ws + WS_XB);
        f32x4 gv[8];
#pragma unroll
        for (int j = 0; j < 8; ++j) gv[j] = gf[64 * j];
        for (int row = gw; row < MT; row += 2 * NGW) {
            const int row2 = row + NGW; const bool two = row2 < MT; const int rb = two ? row2 : row;
            const u32x2* xa = (const u32x2*)(XBf + (size_t)row * DM) + ll; const u32x2* xb2 = (const u32x2*)(XBf + (size_t)rb * DM) + ll;
            u32x2 wa[8], wb[8];
#pragma unroll
            for (int j = 0; j < 8; ++j) wa[j] = xa[64 * j];
#pragma unroll
            for (int j = 0; j < 8; ++j) wb[j] = xb2[64 * j];
            const float pa = ll < 32 ? SSX[(size_t)row * 32 + ll] : 0.f, pb = ll < 32 ? SSX[(size_t)rb * 32 + ll] : 0.f;
            const float ra = __builtin_amdgcn_rsqf(wave_sum(pa) * (1.0f / 2048.0f) + EPS), rbs = __builtin_amdgcn_rsqf(wave_sum(pb) * (1.0f / 2048.0f) + EPS);
            f32x4* oa = (f32x4*)(p.out + (size_t)row * DM) + ll; f32x4* ob = (f32x4*)(p.out + (size_t)rb * DM) + ll;
#pragma unroll
            for (int j = 0; j < 8; ++j) { const u32x2 w = wa[j]; oa[64 * j] = (f32x4){bf_lo(w.x), bf_hi(w.x), bf_lo(w.y), bf_hi(w.y)} * ra * gv[j]; }
            if (two) {
#pragma unroll
                for (int j = 0; j < 8; ++j) { const u32x2 w = wb[j]; ob[64 * j] = (f32x4){bf_lo(w.x), bf_hi(w.x), bf_lo(w.y), bf_hi(w.y)} * rbs * gv[j]; }
            }
        }
    }
}

extern "C" void kernel_launch(void* const* d_in, const int* in_sizes, int n_in, void* d_out, int out_size, void* d_ws, size_t ws_size, hipStream_t stream) {
    static int grid = 0;
    if (grid == 0) {
        if (n_in != 16 || ws_size < WS_END) { fprintf(stderr, "kernel_launch: unexpected n_in %d / ws_size %zu\n", n_in, ws_size); grid = -1; return; }
        int dev = 0, cus = 0, per_cu = 0;
        hipGetDevice(&dev);
        hipDeviceGetAttribute(&cus, hipDeviceAttributeMultiprocessorCount, dev);
        hipFuncSetAttribute((const void*)fwd_megakernel, hipFuncAttributeMaxDynamicSharedMemorySize, LDS_BYTES);
        hipOccupancyMaxActiveBlocksPerMultiprocessor(&per_cu, (const void*)fwd_megakernel, 512, LDS_BYTES);
        if (per_cu < 1) per_cu = 1;
        (void)hipGetLastError();
        grid = cus * per_cu;
        if (grid != 256) { fprintf(stderr, "kernel_launch: this kernel's phase-2 schedule is built for a 256-workgroup grid, got %d\n", grid); grid = -1; return; }
    }
    if (grid < 0) return;
    Params p{};
    p.x_prompt = (const float*)d_in[0]; p.x_sample = (const float*)d_in[1]; p.cache_k = (const float*)d_in[2]; p.cache_v = (const float*)d_in[3];
    p.w_in = (const float*)d_in[4]; p.w_out = (const float*)d_in[5]; p.norm_in = (const float*)d_in[6]; p.rel_bias = (const float*)d_in[7]; p.sinks = (const float*)d_in[8];
    p.norm_attn = (const float*)d_in[9]; p.norm_gmlp = (const float*)d_in[10]; p.ln_v_g = (const float*)d_in[11]; p.ln_v_b = (const float*)d_in[12];
    p.w_spatial = (const float*)d_in[13]; p.b_spatial = (const float*)d_in[14]; p.norm_final = (const float*)d_in[15];
    p.out = (float*)d_out; p.ws = (unsigned char*)d_ws;
    (void)hipMemsetAsync((unsigned char*)d_ws + WS_CNT, 0, 65536, stream);
    void* args[] = {&p};
    hipError_t e = hipLaunchCooperativeKernel((const void*)fwd_megakernel, dim3(grid), dim3(512), args, LDS_BYTES, stream);
    if (e != hipSuccess) fprintf(stderr, "cooperative launch failed: %s (grid %d)\n", hipGetErrorString(e), grid);
}
```
